# Optimizing an MI355X kernel written in HIP

```python
import jax, jax.numpy as jnp
from jax import lax
import numpy as np

D_MODEL = 1024
BATCH = 4
SEQ = 4096
DEPTH = 4

CHUNK = 64
N_MIXERS = 2
EPS = 1e-6

SSD_EXPAND = 2
SSD_D_INNER = SSD_EXPAND * D_MODEL
SSD_HEAD_DIM = 64
SSD_N_HEADS = SSD_D_INNER // SSD_HEAD_DIM
SSD_N_GROUPS = 8
SSD_HEADS_PER_GROUP = SSD_N_HEADS // SSD_N_GROUPS
SSD_D_STATE = 128
SSD_CONV_W = 4
SSD_BC_DIM = SSD_N_GROUPS * SSD_D_STATE
SSD_CONV_DIM = SSD_D_INNER + 2 * SSD_BC_DIM
SSD_IN_DIM = SSD_D_INNER + SSD_CONV_DIM + SSD_N_HEADS

SC_WIDTH = D_MODEL
SC_CONV_W = 3

FFN_HIDDEN = 2816
FFN_CONV_W = 3

N_SSD_LAYERS = (DEPTH + 1) // 2
N_SC_LAYERS = DEPTH // 2

kernel_name = "hybrid_ssd_shortconv_convffn_sandwich"


def rms_norm(x, g):
    xf = x.astype(jnp.float32)
    y = xf * lax.rsqrt(jnp.mean(xf * xf, axis=-1, keepdims=True) + EPS)
    return (y * g.astype(jnp.float32)).astype(x.dtype)


def causal_dwconv(x, w, b=None):
    k = w.shape[0]
    length = x.shape[1]
    xp = jnp.pad(x, ((0, 0), (k - 1, 0), (0, 0)))
    out = xp[:, 0:length] * w[0]
    for t in range(1, k):
        out = out + xp[:, t:t + length] * w[t]
    if b is not None:
        out = out + b
    return out


def ssd_scan(x, dt, a_head, b_in, c_in):
    bsz, length, h, p = x.shape
    g, n = b_in.shape[2], b_in.shape[3]
    r = h // g
    nc = length // CHUNK
    xf = (x.astype(jnp.float32) * dt[..., None]).reshape(bsz, nc, CHUNK, g, r, p)
    a = (dt * a_head).reshape(bsz, nc, CHUNK, g, r)
    a = jnp.moveaxis(a, 2, -1)
    a_cs = jnp.cumsum(a, axis=-1)
    bc = b_in.astype(jnp.float32).reshape(bsz, nc, CHUNK, g, n)
    cc = c_in.astype(jnp.float32).reshape(bsz, nc, CHUNK, g, n)
    seg = a_cs[..., :, None] - a_cs[..., None, :]
    tri = jnp.tril(jnp.ones((CHUNK, CHUNK), dtype=bool))
    lmat = jnp.exp(jnp.where(tri, seg, -jnp.inf))
    cb = jnp.einsum("bclgn,bcsgn->bcgls", cc, bc)
    y_diag = jnp.einsum("bcgls,bcgrls,bcsgrp->bclgrp", cb, lmat, xf)
    decay_states = jnp.exp(a_cs[..., -1:] - a_cs)
    states = jnp.einsum("bclgn,bcgrl,bclgrp->bcgrpn", bc, decay_states, xf)
    chunk_decay = jnp.exp(a_cs[..., -1])

    def step(s, inp):
        st, dec = inp
        return s * dec[..., None, None] + st, s

    init = jnp.zeros((bsz, g, r, p, n), jnp.float32)
    _, prev = lax.scan(step, init, (jnp.moveaxis(states, 1, 0), jnp.moveaxis(chunk_decay, 1, 0)))
    prev = jnp.moveaxis(prev, 0, 1)
    y_off = jnp.einsum("bclgn,bcgrpn,bcgrl->bclgrp", cc, prev, jnp.exp(a_cs))
    return (y_diag + y_off).reshape(bsz, length, h, p)


def ssd_mixer(h, w_in, conv_w, conv_b, dt_bias, a_log, d_skip, norm_w, w_out):
    bsz, length, _ = h.shape
    zxbcdt = h @ w_in
    z = zxbcdt[..., :SSD_D_INNER]
    xbc = zxbcdt[..., SSD_D_INNER:SSD_D_INNER + SSD_CONV_DIM]
    dt_raw = zxbcdt[..., SSD_D_INNER + SSD_CONV_DIM:]
    xbc = jax.nn.silu(causal_dwconv(xbc, conv_w, conv_b))
    xs = xbc[..., :SSD_D_INNER].reshape(bsz, length, SSD_N_HEADS, SSD_HEAD_DIM)
    bs = xbc[..., SSD_D_INNER:SSD_D_INNER + SSD_BC_DIM].reshape(bsz, length, SSD_N_GROUPS, SSD_D_STATE)
    cs = xbc[..., SSD_D_INNER + SSD_BC_DIM:].reshape(bsz, length, SSD_N_GROUPS, SSD_D_STATE)
    dt = jax.nn.softplus(dt_raw.astype(jnp.float32) + dt_bias.astype(jnp.float32))
    a_head = -jnp.exp(a_log.astype(jnp.float32))
    y = ssd_scan(xs, dt, a_head, bs, cs)
    y = y + xs.astype(jnp.float32) * d_skip.astype(jnp.float32)[:, None]
    y = y.reshape(bsz, length, SSD_D_INNER).astype(h.dtype)
    y = rms_norm(y * jax.nn.silu(z), norm_w)
    return y @ w_out


def shortconv_mixer(h, w_in, conv_w, w_out):
    bcv = h @ w_in
    gb = bcv[..., :SC_WIDTH]
    gc = bcv[..., SC_WIDTH:2 * SC_WIDTH]
    v = bcv[..., 2 * SC_WIDTH:]
    u = causal_dwconv(gc * v, conv_w)
    return (gb * u) @ w_out


def conv_ffn(h, w_up, conv_w, conv_b, w_down):
    up = h @ w_up
    gate = causal_dwconv(up[..., :FFN_HIDDEN], conv_w, conv_b)
    val = up[..., FFN_HIDDEN:]
    return (jax.nn.silu(gate) * val) @ w_down


def setup_inputs(seed: int = 0) -> dict:
    key = jax.random.key(seed)
    ks = jax.random.split(key, 20)
    f32 = jnp.float32
    nrm = lambda k, shape, s: jax.random.normal(k, shape, f32) * s
    x = jax.random.normal(ks[0], (BATCH, SEQ, D_MODEL), f32)
    gains = lambda k: 1.0 + nrm(k, (DEPTH, D_MODEL), 0.02)
    dt0 = jnp.exp(jax.random.uniform(ks[8], (N_SSD_LAYERS, SSD_N_HEADS), f32,
                                     np.float32(np.log(1e-3)), np.float32(np.log(1e-1))))
    return {
        "x": x,
        "mix_pre_g": gains(ks[1]),
        "mix_post_g": gains(ks[2]),
        "ffn_pre_g": gains(ks[3]),
        "ffn_post_g": gains(ks[4]),
        "ssd_w_in": nrm(ks[5], (N_SSD_LAYERS, D_MODEL, SSD_IN_DIM), D_MODEL ** -0.5),
        "ssd_conv_w": nrm(ks[6], (N_SSD_LAYERS, SSD_CONV_W, SSD_CONV_DIM), SSD_CONV_W ** -0.5),
        "ssd_conv_b": nrm(ks[7], (N_SSD_LAYERS, SSD_CONV_DIM), 0.01),
        "ssd_dt_bias": dt0 + jnp.log(-jnp.expm1(-dt0)),
        "ssd_A_log": jnp.log(jax.random.uniform(ks[9], (N_SSD_LAYERS, SSD_N_HEADS), f32, 1.0, 16.0)),
        "ssd_D": 1.0 + nrm(ks[10], (N_SSD_LAYERS, SSD_N_HEADS), 0.1),
        "ssd_norm_w": 1.0 + nrm(ks[11], (N_SSD_LAYERS, SSD_D_INNER), 0.02),
        "ssd_w_out": nrm(ks[12], (N_SSD_LAYERS, SSD_D_INNER, D_MODEL), SSD_D_INNER ** -0.5),
        "sc_w_in": nrm(ks[13], (N_SC_LAYERS, D_MODEL, 3 * SC_WIDTH), D_MODEL ** -0.5),
        "sc_conv_w": nrm(ks[14], (N_SC_LAYERS, SC_CONV_W, SC_WIDTH), SC_CONV_W ** -0.5),
        "sc_w_out": nrm(ks[15], (N_SC_LAYERS, SC_WIDTH, D_MODEL), SC_WIDTH ** -0.5),
        "ffn_w_up": nrm(ks[16], (DEPTH, D_MODEL, 2 * FFN_HIDDEN), D_MODEL ** -0.5),
        "ffn_conv_w": nrm(ks[17], (DEPTH, FFN_CONV_W, FFN_HIDDEN), FFN_CONV_W ** -0.5),
        "ffn_conv_b": nrm(ks[18], (DEPTH, FFN_HIDDEN), 0.01),
        "ffn_w_down": nrm(ks[19], (DEPTH, FFN_HIDDEN, D_MODEL), FFN_HIDDEN ** -0.5),
    }


def reference(x, mix_pre_g, mix_post_g, ffn_pre_g, ffn_post_g,
              ssd_w_in, ssd_conv_w, ssd_conv_b, ssd_dt_bias, ssd_A_log, ssd_D,
              ssd_norm_w, ssd_w_out, sc_w_in, sc_conv_w, sc_w_out,
              ffn_w_up, ffn_conv_w, ffn_conv_b, ffn_w_down):
    for i in range(DEPTH):
        j = i // N_MIXERS
        h = rms_norm(x, mix_pre_g[i])
        if i % N_MIXERS == 0:
            m = ssd_mixer(h, ssd_w_in[j], ssd_conv_w[j], ssd_conv_b[j], ssd_dt_bias[j],
                          ssd_A_log[j], ssd_D[j], ssd_norm_w[j], ssd_w_out[j])
        else:
            m = shortconv_mixer(h, sc_w_in[j], sc_conv_w[j], sc_w_out[j])
        x = x + rms_norm(m, mix_post_g[i])
        f = conv_ffn(rms_norm(x, ffn_pre_g[i]), ffn_w_up[i], ffn_conv_w[i], ffn_conv_b[i], ffn_w_down[i])
        x = x + rms_norm(f, ffn_post_g[i])
    return x
```

```cpp
#include <hip/hip_runtime.h>
#include <hip/hip_cooperative_groups.h>
#include <cstdio>
#include <cstdint>
namespace cg = cooperative_groups;

#ifndef ONE_LAUNCH
#define ONE_LAUNCH 1
#endif
#ifndef FAST_SSD
#define FAST_SSD 1
#endif
#ifndef PROBE
#define PROBE 0
#endif
#ifndef HIDE_CONV
#define HIDE_CONV 0
#endif
#ifndef FUSE_RESID
#define FUSE_RESID 1
#endif
#ifndef FAST_GEMM
#define FAST_GEMM 1
#endif

#define LAS __attribute__((address_space(3)))
typedef unsigned short bf16_t;
typedef short bf16x8 __attribute__((ext_vector_type(8)));
typedef short s16x4 __attribute__((ext_vector_type(4)));
typedef float f32x4 __attribute__((ext_vector_type(4)));
typedef unsigned u32x4 __attribute__((ext_vector_type(4)));
typedef unsigned u32x2 __attribute__((ext_vector_type(2)));

constexpr int M_ = 16384, D_ = 1024, SEQ_ = 4096;
constexpr int SSD_IN_N = 6176, SSD_IN_PAD = 6400, BIGW = 6144, DI_ = 2048;
constexpr int SCW3 = 3072, FH = 2816, FH2 = 5632;
constexpr float EPS_ = 1e-6f;
constexpr int NTHREADS = 512, NWAVES = 8;
constexpr int LDS_BYTES = 131072 + 16 + 4096;
constexpr int LDS_RSC = 131072 + 16;

constexpr size_t SZ_SSDIN1 = (size_t)SSD_IN_PAD * 1024 * 2;
constexpr size_t SZ_SSDOUT1 = (size_t)1024 * 2048 * 2;
constexpr size_t SZ_SCIN1 = (size_t)3072 * 1024 * 2;
constexpr size_t SZ_SCOUT1 = (size_t)1024 * 1024 * 2;
constexpr size_t SZ_FUP1 = (size_t)FH2 * 1024 * 2;
constexpr size_t SZ_FDN1 = (size_t)1024 * FH * 2;
constexpr size_t WS_SSDIN = 0;
constexpr size_t WS_SSDOUT = WS_SSDIN + 2 * SZ_SSDIN1;
constexpr size_t WS_SCIN = WS_SSDOUT + 2 * SZ_SSDOUT1;
constexpr size_t WS_SCOUT = WS_SCIN + 2 * SZ_SCIN1;
constexpr size_t WS_FUP = WS_SCOUT + 2 * SZ_SCOUT1;
constexpr size_t WS_FDN = WS_FUP + 4 * SZ_FUP1;
constexpr size_t WS_XB = WS_FDN + 4 * SZ_FDN1;
constexpr size_t WS_BIG = WS_XB + (size_t)M_ * 1024 * 2;
constexpr size_t WS_DT = WS_BIG + (size_t)M_ * BIGW * 2;
constexpr size_t WS_HALO = WS_DT + (size_t)M_ * 32 * 4;
constexpr size_t WS_SSQ128 = WS_HALO;
constexpr size_t WS_SIDEG = WS_HALO;
constexpr size_t WS_SIDEV = WS_SIDEG + (size_t)256 * 4 * FH * 2;
constexpr size_t WS_RSX = WS_SIDEV + (size_t)256 * 2 * FH * 2;
constexpr size_t WS_SSQP = WS_RSX + (size_t)M_ * 16;
constexpr size_t WS_SSQY = WS_SSQP + (size_t)M_ * 16 * 4;
constexpr size_t WS_BAR = WS_SSQY + (size_t)2 * M_ * 8;
constexpr size_t WS_CNT = WS_BAR + 16384;
constexpr size_t WS_XCH = WS_CNT + 16384;
constexpr size_t WS_END = WS_XCH + (size_t)64 * 4 * 256 * 4;
constexpr float SSQ_FIX = 16777216.f, SSQ_UNFIX = 1.0f / 16777216.f;
static_assert(WS_END <= 369098752ull, "workspace budget");

#if HIDE_CONV
constexpr unsigned CONV_PREP_MASK = 0x0001u;
#else
constexpr unsigned CONV_PREP_MASK = 0xFFFFu;
#endif
struct Args { const float* in[20]; float* out; unsigned char* ws; int ph_lo, ph_hi; };

__device__ __forceinline__ unsigned pk2(float lo, float hi) { unsigned r; asm volatile("v_cvt_pk_bf16_f32 %0, %1, %2" : "=v"(r) : "v"(lo), "v"(hi)); return r; }
__device__ __forceinline__ float bf_lo(unsigned w) { return __uint_as_float(w << 16); }
__device__ __forceinline__ float bf_hi(unsigned w) { return __uint_as_float(w & 0xffff0000u); }
__device__ __forceinline__ float bf2f(bf16_t h) { return __uint_as_float(((unsigned)h) << 16); }
__device__ __forceinline__ void unpack8(const uint4 v, float* f) {
    f[0] = bf_lo(v.x); f[1] = bf_hi(v.x); f[2] = bf_lo(v.y); f[3] = bf_hi(v.y); f[4] = bf_lo(v.z); f[5] = bf_hi(v.z); f[6] = bf_lo(v.w); f[7] = bf_hi(v.w);
}
__device__ __forceinline__ uint4 pack8(const float* f) { uint4 o; o.x = pk2(f[0], f[1]); o.y = pk2(f[2], f[3]); o.z = pk2(f[4], f[5]); o.w = pk2(f[6], f[7]); return o; }
__device__ __forceinline__ float silu_f(float x) { return x * __builtin_amdgcn_rcpf(1.0f + __expf(-x)); }
__device__ __forceinline__ float softplus_f(float x) { return x > 20.f ? x : log1pf(__expf(x)); }
__device__ __forceinline__ int opaque_tid() { int t = threadIdx.x; asm volatile("" : "+v"(t)); return t; }
__device__ __forceinline__ float rsx(const float* ssqx, int row) { const f32x4 p = *(const f32x4*)(ssqx + (size_t)row * 4); return rsqrtf(((p[0] + p[1]) + (p[2] + p[3])) * (1.0f / 1024.f) + EPS_); }
__device__ __forceinline__ float wave_sum(float v) {
#pragma unroll
    for (int o = 1; o < 64; o <<= 1) v += __shfl_xor(v, o);
    return v;
}


struct RsCache { LAS float* tab; int pm; };
__device__ __forceinline__ void rs_cache_fill(RsCache& C, const float* ssqx, int pm, int wr, int lane) {
    if (C.pm != pm) {
        C.tab[lane] = rsx(ssqx, pm * 256 + wr * 64 + lane); C.tab[64 + lane] = rsx(ssqx, pm * 256 + 128 + wr * 64 + lane);
        C.pm = pm;
    }
}

#define XB_TMO      128
#define XB_XCNT(j)  (256  + 64 * (j))
#define XB_XSUB(j)  (1280 + 64 * (j))
#define XB_XGEN(j)  (2304 + 64 * (j))
#define XB_TOP      3328
#define XB_TOPGEN   3392
#define XCD_BAR_WORDS 3456
#define XB_SPIN_CAP (1u << 20)
__device__ __forceinline__ unsigned xb_ld(unsigned* p)              { return __hip_atomic_load(p, __ATOMIC_RELAXED, __HIP_MEMORY_SCOPE_AGENT); }
__device__ __forceinline__ unsigned xb_add(unsigned* p, unsigned v) { return __hip_atomic_fetch_add(p, v, __ATOMIC_RELAXED, __HIP_MEMORY_SCOPE_AGENT); }
__device__ __forceinline__ unsigned xb_xcc_id() { return (unsigned)__builtin_amdgcn_s_getreg((3 << 11) | 20) & 0xFu; }
#define XB_SPIN(cond, bar) do { unsigned _sp = 0; while (cond) { \
    if ((++_sp & 255u) == 0u) { if (xb_ld(&(bar)[XB_TMO])) break; if (_sp > XB_SPIN_CAP) { atomicAdd(&(bar)[XB_TMO], 1u); break; } } } } while (0)
struct XcdBarrier { unsigned* bar; unsigned x; volatile LAS unsigned* st; };
__device__ __forceinline__ XcdBarrier xcd_barrier_post(unsigned* bar, volatile LAS unsigned* st) {
    XcdBarrier b; b.bar = bar; b.x = xb_xcc_id(); b.st = st;
    if (threadIdx.x == 0) (void)xb_add(&bar[XB_XCNT(b.x)], 1u);
    return b;
}
__device__ __forceinline__ void xcd_barrier_complete(unsigned* bar, unsigned x, unsigned& nloc, unsigned& nx) {
    const unsigned G = gridDim.x * gridDim.y * gridDim.z;
    unsigned sum, cnt, mine, sp = 0u;
    for (;;) {
        sum = 0u; cnt = 0u; mine = 0u;
#pragma unroll
        for (unsigned jx = 0; jx < 16; ++jx) { const unsigned c = xb_ld(&bar[XB_XCNT(jx)]); sum += c; cnt += (c > 0u) ? 1u : 0u; mine = (jx == x) ? c : mine; }
        if (sum == G) break;
        __builtin_amdgcn_s_sleep(1);
        if ((++sp & 255u) == 0u) { if (xb_ld(&bar[XB_TMO])) break; if (sp > XB_SPIN_CAP) { atomicAdd(&bar[XB_TMO], 1u); break; } }
    }
    nloc = mine > 0u ? mine : 1u; nx = cnt > 0u ? cnt : 1u;
}
__device__ __forceinline__ void xcd_barrier(const XcdBarrier& b) {
    asm volatile("s_waitcnt vmcnt(0)" ::: "memory");
    __syncthreads();
    if (threadIdx.x == 0) {
        unsigned* bar = b.bar;
        __builtin_amdgcn_s_waitcnt(0);
        unsigned nloc = b.st[0], nx = b.st[1];
        if (nloc == 0u) { xcd_barrier_complete(bar, b.x, nloc, nx); b.st[0] = nloc; b.st[1] = nx; }
        const unsigned old = xb_add(&bar[XB_XSUB(b.x)], 1u);
        const unsigned gen = old / nloc;
        if (old + 1u == (gen + 1u) * nloc) {
            __builtin_amdgcn_fence(__ATOMIC_RELEASE, "agent");
            asm volatile("s_waitcnt vmcnt(0)" ::: "memory");
            const unsigned og = xb_add(&bar[XB_TOP], 1u);
            const unsigned tg = og / nx;
            if (og + 1u == (tg + 1u) * nx) xb_add(&bar[XB_TOPGEN], 1u);
            else XB_SPIN(xb_ld(&bar[XB_TOPGEN]) == tg, bar);
            __builtin_amdgcn_fence(__ATOMIC_ACQUIRE, "agent");
            xb_add(&bar[XB_XGEN(b.x)], 1u);
            asm volatile("s_waitcnt vmcnt(0)" ::: "memory");
        } else {
            XB_SPIN(xb_ld(&bar[XB_XGEN(b.x)]) == gen, bar);
            __builtin_amdgcn_fence(__ATOMIC_ACQUIRE, "agent");
            asm volatile("s_waitcnt vmcnt(0)" ::: "memory");
        }
    }
    __syncthreads();
}

namespace pg8 {
constexpr int BM = 256, BK = 64, HALF = 128, HTB = HALF * BK * 2, STAGE_BYTES = 8 * HTB, NXCD = 8, WGM = 8;
__host__ __device__ __forceinline__ int lds_byte(int r, int c) { const int st = (r >> 4) * 2 + (c >> 5), rr = r & 15, cc = c & 31, ob = rr * 64 + cc * 2; return st * 1024 + (ob ^ (((ob >> 9) & 1) << 5)); }
__host__ __device__ __forceinline__ void stage_rc(int b, int& R, int& C) { const int st = b / 1024, sb = b % 1024, swz = sb ^ (((sb >> 9) & 1) << 5); R = (st >> 1) * 16 + swz / 64; C = (st & 1) * 32 + (swz % 64) / 2; }
__host__ __device__ __forceinline__ int perm32(int rho) { const int n = rho >> 4, i = rho & 15; return 8 * (i >> 2) + 4 * n + (i & 3); }
struct Unit { int pm, pn; };
struct Gemm { const bf16_t* A; int lda; const bf16_t* Bt; int M, N, K; };
struct StaticOrder {
    int nM, nN, nwg, G, c;
    __host__ __device__ void init(int M, int N, int G_, int c_) { nM = M / BM; nN = N / BM; nwg = nM * nN; G = G_; c = c_; }
    __host__ __device__ bool next(int i, Unit& u) const {
        const long L = (long)i * G + c; if (L >= nwg) return false;
        int wgid = (int)L; { const int q = nwg / NXCD, r = nwg % NXCD, xcd = wgid % NXCD, off = wgid / NXCD; wgid = (xcd < r ? xcd * (q + 1) : r * (q + 1) + (xcd - r) * q) + off; }
        const int nig = WGM * nN, gid = wgid / nig, fm = gid * WGM, gsz = (nM - fm) < WGM ? (nM - fm) : WGM;
        u.pm = fm + ((wgid % nig) % gsz); u.pn = (wgid % nig) / gsz; return true;
    }
};

template <class Epi, bool ALIGN_EPI = true>
__device__ __forceinline__ void gemm_phase(LAS unsigned char* lds, const Gemm g, const StaticOrder& S, const Epi& E) {
    const int tid = opaque_tid(), wid = __builtin_amdgcn_readfirstlane(tid >> 6), lane = tid & 63, wr = wid >> 2, wc = wid & 3, fr = lane & 15, fq = lane >> 4;
    const int K = g.K, nt = K / BK, lda = g.lda;
    unsigned voffA[2], voffB[2];
#pragma unroll
    for (int i = 0; i < 2; ++i) { int R, C; stage_rc(tid * 16 + i * 8192, R, C); const int Rb = (R & ~31) + perm32(R & 31); voffA[i] = (unsigned)(R * lda + C) * 2u; voffB[i] = (unsigned)(Rb * K + C) * 2u; }
    const size_t kstep = (size_t)(BK * 2);
    const size_t hsA = (size_t)HALF * lda * 2, hsB = (size_t)HALF * K * 2;
    const size_t tsA = 2 * hsA, tsB = 2 * hsB;
    const unsigned ldsw = (unsigned)wid * 1024u;
    const int aoff = lds_byte(wr * 64 + fr, fq * 8), boff = lds_byte(wc * 32 + fr, fq * 8);
#define PG8_SA(b, h) (((b) * 2 + (h)) * HTB)
#define PG8_SB(b, h) ((4 + (b) * 2 + (h)) * HTB)
#define PG8_STAGE(bufoff, gbase, voff) do { _Pragma("unroll") for (int _i = 0; _i < 2; ++_i) \
        __builtin_amdgcn_global_load_lds((const unsigned*)((const char*)(gbase) + (voff)[_i]), (LAS unsigned*)(lds + (bufoff) + ldsw + _i * 8192), 16, 0, 0); } while (0)
#define PG8_LDA(dst, b, h) do { _Pragma("unroll") for (int m = 0; m < 4; ++m) _Pragma("unroll") for (int k = 0; k < 2; ++k) dst[m][k] = *(const LAS bf16x8*)(lds + PG8_SA(b, h) + aoff + m * 2048 + k * 1024); } while (0)
#define PG8_LDB(dst, b, h) do { _Pragma("unroll") for (int n = 0; n < 2; ++n) _Pragma("unroll") for (int k = 0; k < 2; ++k) dst[n][k] = *(const LAS bf16x8*)(lds + PG8_SB(b, h) + boff + n * 2048 + k * 1024); } while (0)
#define PG8_MMA(ai, bj, At, Bt) do { __builtin_amdgcn_s_setprio(1); _Pragma("unroll") for (int m = 0; m < 4; ++m) _Pragma("unroll") for (int n = 0; n < 2; ++n) _Pragma("unroll") for (int k = 0; k < 2; ++k) \
        acc[ai][bj][m][n] = __builtin_amdgcn_mfma_f32_16x16x32_bf16(Bt[n][k], At[m][k], acc[ai][bj][m][n], 0, 0, 0); __builtin_amdgcn_s_setprio(0); } while (0)
#define PG8_WAIT_V(n) asm volatile("s_waitcnt vmcnt(" #n ")" ::: "memory")
#define PG8_WAIT_L(n) asm volatile("s_waitcnt lgkmcnt(" #n ")" ::: "memory")
#define PG8_BAR __builtin_amdgcn_s_barrier()
#define PG8_SCHED __builtin_amdgcn_sched_barrier(0)
    Unit cur, nxt; int ui = 0;
    if (!S.next(0, cur)) return;
    RsCache rsc; rsc.tab = (LAS float*)(lds + LDS_RSC + wid * 512); rsc.pm = -1;
    f32x4 acc[2][2][4][2];
#pragma unroll
    for (int a = 0; a < 2; ++a)
#pragma unroll
        for (int b = 0; b < 2; ++b)
#pragma unroll
            for (int m = 0; m < 4; ++m)
#pragma unroll
                for (int n = 0; n < 2; ++n) acc[a][b][m][n] = (f32x4){0.f, 0.f, 0.f, 0.f};
    bf16x8 At[4][2], B0[2][2], B1[2][2];
    const char* cA = (const char*)g.A + (size_t)cur.pm * tsA; const char* cB = (const char*)g.Bt + (size_t)cur.pn * tsB;
    PG8_STAGE(PG8_SB(0, 0), cB, voffB); PG8_STAGE(PG8_SB(0, 1), cB + hsB, voffB); PG8_STAGE(PG8_SA(0, 0), cA, voffA); PG8_STAGE(PG8_SA(0, 1), cA + hsA, voffA);
    if (wr == 1) PG8_BAR;
    PG8_WAIT_V(2); PG8_BAR;
    PG8_STAGE(PG8_SB(1, 0), cB + kstep, voffB); PG8_STAGE(PG8_SA(1, 0), cA + kstep, voffA); PG8_STAGE(PG8_SB(1, 1), cB + hsB + kstep, voffB);
    PG8_WAIT_V(6); PG8_BAR;
    for (;;) {
        const bool has_next = S.next(ui + 1, nxt);
        const char* nA = has_next ? (const char*)g.A + (size_t)nxt.pm * tsA : cA; const char* nB = has_next ? (const char*)g.Bt + (size_t)nxt.pn * tsB : cB;
        for (int t = 0; t < nt; t += 2) {
            const bool last = (t == nt - 2);
            const char* a1 = cA + (size_t)(t + 1) * kstep;
            const char* a2 = last ? nA : cA + (size_t)(t + 2) * kstep; const char* b2 = last ? nB : cB + (size_t)(t + 2) * kstep;
            const char* a3 = a2 + kstep; const char* b3 = b2 + kstep;
            PG8_LDB(B0, 0, 0); PG8_LDB(B1, 0, 1); PG8_SCHED; PG8_LDA(At, 0, 0); PG8_STAGE(PG8_SA(1, 1), a1 + hsA, voffA);
            PG8_WAIT_V(8); PG8_WAIT_L(0); PG8_BAR; PG8_MMA(0, 0, At, B0); PG8_MMA(0, 1, At, B1); PG8_BAR; PG8_SCHED;
            PG8_LDA(At, 0, 1); PG8_STAGE(PG8_SB(0, 0), b2, voffB); PG8_STAGE(PG8_SB(0, 1), b2 + hsB, voffB); PG8_STAGE(PG8_SA(0, 0), a2, voffA);
            PG8_WAIT_V(8); PG8_WAIT_L(0); PG8_BAR; PG8_MMA(1, 0, At, B0); PG8_MMA(1, 1, At, B1); PG8_BAR; PG8_SCHED;
            PG8_LDB(B0, 1, 0); PG8_LDB(B1, 1, 1); PG8_SCHED; PG8_LDA(At, 1, 0); PG8_STAGE(PG8_SA(0, 1), a2 + hsA, voffA);
            PG8_WAIT_V(8); PG8_WAIT_L(0); PG8_BAR; PG8_MMA(0, 0, At, B0); PG8_MMA(0, 1, At, B1); PG8_BAR; PG8_SCHED;
            PG8_LDA(At, 1, 1); PG8_STAGE(PG8_SB(1, 0), b3, voffB); PG8_STAGE(PG8_SB(1, 1), b3 + hsB, voffB); PG8_STAGE(PG8_SA(1, 0), a3, voffA);
            PG8_WAIT_V(8); PG8_WAIT_L(0); PG8_BAR; PG8_MMA(1, 0, At, B0); PG8_MMA(1, 1, At, B1); PG8_BAR; PG8_SCHED;
        }
        if constexpr (ALIGN_EPI) { if (wr == 0) PG8_BAR; }
        if constexpr (!Epi::AFTER_DRAIN) E.fast(acc, cur, wr, wc, fr, fq, rsc);
        if (!has_next) break;
#pragma unroll
        for (int a = 0; a < 2; ++a)
#pragma unroll
            for (int b = 0; b < 2; ++b)
#pragma unroll
                for (int m = 0; m < 4; ++m)
#pragma unroll
                    for (int n = 0; n < 2; ++n) acc[a][b][m][n] = (f32x4){0.f, 0.f, 0.f, 0.f};
        cur = nxt; cA = nA; cB = nB; ++ui;
        if constexpr (ALIGN_EPI) { if (wr == 1) PG8_BAR; }
    }
    PG8_WAIT_V(0);
    if constexpr (!ALIGN_EPI) { if (wr == 0) PG8_BAR; }
    PG8_BAR;
    if constexpr (Epi::AFTER_DRAIN) E.fused(acc, cur, wr, wc, fr, fq, lds, wid, lane);
#undef PG8_SA
#undef PG8_SB
#undef PG8_STAGE
#undef PG8_LDA
#undef PG8_LDB
#undef PG8_MMA
#undef PG8_WAIT_V
#undef PG8_WAIT_L
#undef PG8_BAR
#undef PG8_SCHED
}
}

template <class Epi>
__device__ __forceinline__ void gemm_naive(float* ldsf, const bf16_t* A, int lda, const bf16_t* Bt, int N, int K, const Epi& E) {
    float* As = ldsf;
    float* Bs = ldsf + 32 * 132;
    const int tid = opaque_tid(), tx = tid & 15, ty = tid >> 4;
    const int ntn = N / 64, ntiles = (M_ / 128) * ntn;
    for (int tile = blockIdx.x; tile < ntiles; tile += gridDim.x) {
        const int tm = tile / ntn, tn = tile % ntn, row0 = tm * 128, col0 = tn * 64;
        float acc[4][4];
#pragma unroll
        for (int i = 0; i < 4; ++i)
#pragma unroll
            for (int jj = 0; jj < 4; ++jj) acc[i][jj] = 0.f;
        for (int k0 = 0; k0 < K; k0 += 32) {
            __syncthreads();
            { const int r = tid >> 2, kc = (tid & 3) * 8; const uint4 v = *(const uint4*)(A + (size_t)(row0 + r) * lda + k0 + kc); float f[8]; unpack8(v, f);
#pragma unroll
              for (int i = 0; i < 8; ++i) As[(kc + i) * 132 + r] = f[i]; }
            if (tid < 256) { const int n = tid >> 2, kc = (tid & 3) * 8; const uint4 v = *(const uint4*)(Bt + (size_t)(col0 + n) * K + k0 + kc); float f[8]; unpack8(v, f);
#pragma unroll
              for (int i = 0; i < 8; ++i) Bs[(kc + i) * 68 + n] = f[i]; }
            __syncthreads();
#pragma unroll 8
            for (int k = 0; k < 32; ++k) {
                const float4 a4 = *(const float4*)&As[k * 132 + ty * 4]; const float4 b4 = *(const float4*)&Bs[k * 68 + tx * 4];
                const float av[4] = {a4.x, a4.y, a4.z, a4.w}, bv[4] = {b4.x, b4.y, b4.z, b4.w};
#pragma unroll
                for (int i = 0; i < 4; ++i)
#pragma unroll
                    for (int jj = 0; jj < 4; ++jj) acc[i][jj] += av[i] * bv[jj];
            }
        }
#pragma unroll
        for (int i = 0; i < 4; ++i) {
            const int row = row0 + ty * 4 + i; const float rs = E.row_scale(row);
            float s = E.apply4(row, col0 + tx * 4, (f32x4){acc[i][0], acc[i][1], acc[i][2], acc[i][3]}, rs);
            if (Epi::SSQ) { s += __shfl_xor(s, 1); s += __shfl_xor(s, 2); s += __shfl_xor(s, 4); s += __shfl_xor(s, 8); if (tx == 0) E.put_ssq(row, tn, s); }
        }
    }
    __syncthreads();
}


struct EpiSsdIn {
    static constexpr bool AFTER_DRAIN = false;
    static constexpr bool SSQ = false;
    bf16_t* big; float* dt; bf16_t* halo; const float* rs; const float* dt_bias;
    __device__ __forceinline__ float row_scale(int row) const { return rsx(rs, row); }
    __device__ __forceinline__ float apply4(int row, int col, f32x4 v, float s) const {
        v = v * s;
        if (col < BIGW) {
            u32x2 w; w.x = pk2(v[0], v[1]); w.y = pk2(v[2], v[3]);
            *(u32x2*)(big + (size_t)row * BIGW + col) = w;
            if (col >= DI_ && (row & 63) >= 61) *(u32x2*)(halo + ((size_t)(row >> 6) * 3 + ((row & 63) - 61)) * 4096 + (col - DI_)) = w;
        } else if (col < SSD_IN_N) {
            const f32x4 b = *(const f32x4*)(dt_bias + (col - BIGW));
            f32x4 o; o[0] = softplus_f(v[0] + b[0]); o[1] = softplus_f(v[1] + b[1]); o[2] = softplus_f(v[2] + b[2]); o[3] = softplus_f(v[3] + b[3]);
            *(f32x4*)(dt + (size_t)row * 32 + (col - BIGW)) = o;
        }
        return 0.f;
    }
    __device__ __forceinline__ void put_ssq(int, int, float) const {}
    __device__ __forceinline__ void fast(const f32x4 (&acc)[2][2][4][2], const pg8::Unit& u, int wr, int wc, int fr, int fq, RsCache& rsc) const {
        asm volatile("" : "+v"(fr), "+v"(fq));
        rs_cache_fill(rsc, rs, u.pm, wr, fq * 16 + fr);
        const int row0 = u.pm * 256 + wr * 64 + fr;
        if (u.pn < 24) {
            const int cb = u.pn * 256 + wc * 32 + 8 * fq; const bool hal = (u.pn >= 8) && (fr >= 13);
#pragma unroll
            for (int ai = 0; ai < 2; ++ai)
#pragma unroll
                for (int m = 0; m < 4; ++m) { const int row = row0 + ai * 128 + m * 16; const float s = rsc.tab[ai * 64 + m * 16 + fr]; bf16_t* rowp = big + (size_t)row * BIGW + cb;
#pragma unroll
                    for (int bj = 0; bj < 2; ++bj) { const f32x4 v0 = acc[ai][bj][m][0] * s, v1 = acc[ai][bj][m][1] * s;
                        u32x4 w; w.x = pk2(v0[0], v0[1]); w.y = pk2(v0[2], v0[3]); w.z = pk2(v1[0], v1[1]); w.w = pk2(v1[2], v1[3]);
                        *(u32x4*)(rowp + bj * 128) = w;
                        if (m == 3 && hal) *(u32x4*)(halo + ((size_t)(row >> 6) * 3 + (fr - 13)) * 4096 + (cb - DI_) + bj * 128) = w; }
                    asm volatile("" ::: "memory"); }
        } else if (wc == 0) {
            const f32x4 b0 = *(const f32x4*)(dt_bias + 8 * fq), b1 = *(const f32x4*)(dt_bias + 8 * fq + 4);
#pragma unroll
            for (int ai = 0; ai < 2; ++ai)
#pragma unroll
                for (int m = 0; m < 4; ++m) { const int row = row0 + ai * 128 + m * 16; const float s = rsc.tab[ai * 64 + m * 16 + fr];
                    const f32x4 v0 = acc[ai][0][m][0] * s + b0, v1 = acc[ai][0][m][1] * s + b1; f32x4 o0, o1;
#pragma unroll
                    for (int e = 0; e < 4; ++e) { o0[e] = softplus_f(v0[e]); o1[e] = softplus_f(v1[e]); }
                    float* dp = dt + (size_t)row * 32 + 8 * fq; *(f32x4*)dp = o0; *(f32x4*)(dp + 4) = o1;
                    asm volatile("" ::: "memory"); }
        }
    }
};
struct EpiPlain {
    static constexpr bool AFTER_DRAIN = false;
    static constexpr bool SSQ = false;
    bf16_t* out; int ldc; const float* rs;
    __device__ __forceinline__ float row_scale(int row) const { return rsx(rs, row); }
    __device__ __forceinline__ float apply4(int row, int col, f32x4 v, float s) const {
        v = v * s; u32x2 w; w.x = pk2(v[0], v[1]); w.y = pk2(v[2], v[3]);
        *(u32x2*)(out + (size_t)row * ldc + col) = w; return 0.f;
    }
    __device__ __forceinline__ void put_ssq(int, int, float) const {}
    __device__ __forceinline__ void fast(const f32x4 (&acc)[2][2][4][2], const pg8::Unit& u, int wr, int wc, int fr, int fq, RsCache& rsc) const {
        asm volatile("" : "+v"(fr), "+v"(fq));
        rs_cache_fill(rsc, rs, u.pm, wr, fq * 16 + fr);
        const int row0 = u.pm * 256 + wr * 64 + fr;
        if (u.pn < 8) {
            const int cb = 1024 + u.pn * 128 + wc * 32 + 8 * fq;
#pragma unroll
            for (int ai = 0; ai < 2; ++ai)
#pragma unroll
                for (int m = 0; m < 4; ++m) { const int row = row0 + ai * 128 + m * 16; const float s = rsc.tab[ai * 64 + m * 16 + fr]; const float s2 = s * s;
                    const f32x4 v0 = acc[ai][0][m][0] * acc[ai][1][m][0] * s2, v1 = acc[ai][0][m][1] * acc[ai][1][m][1] * s2;
                    u32x4 w; w.x = pk2(v0[0], v0[1]); w.y = pk2(v0[2], v0[3]); w.z = pk2(v1[0], v1[1]); w.w = pk2(v1[2], v1[3]);
                    *(u32x4*)(out + (size_t)row * ldc + cb) = w;
                    asm volatile("" ::: "memory"); }
        } else {
            const int cb = (u.pn - 8) * 256 + wc * 32 + 8 * fq;
#pragma unroll
            for (int ai = 0; ai < 2; ++ai)
#pragma unroll
                for (int m = 0; m < 4; ++m) { const int row = row0 + ai * 128 + m * 16; const float s = rsc.tab[ai * 64 + m * 16 + fr]; bf16_t* rowp = out + (size_t)row * ldc + cb;
#pragma unroll
                    for (int bj = 0; bj < 2; ++bj) { const f32x4 v0 = acc[ai][bj][m][0] * s, v1 = acc[ai][bj][m][1] * s;
                        u32x4 w; w.x = pk2(v0[0], v0[1]); w.y = pk2(v0[2], v0[3]); w.z = pk2(v1[0], v1[1]); w.w = pk2(v1[2], v1[3]);
                        *(u32x4*)(rowp + bj * 128) = w; }
                    asm volatile("" ::: "memory"); }
        }
    }
};
struct EpiOut {
    static constexpr bool AFTER_DRAIN = false;
    static constexpr bool SSQ = true;
    bf16_t* F; int ldf; const float* ssq_in; float inv_k; float* ssqp;
    __device__ __forceinline__ float row_scale(int row) const { if (!ssq_in) return 1.0f; float t = 0.f; for (int k = 0; k < 128; ++k) t += ssq_in[(size_t)k * M_ + row]; return rsqrtf(t * inv_k + EPS_); }
    __device__ __forceinline__ float apply4(int row, int col, f32x4 v, float s) const {
        v = v * s; u32x2 w; w.x = pk2(v[0], v[1]); w.y = pk2(v[2], v[3]);
        *(u32x2*)(F + (size_t)row * ldf + col) = w;
        return (v[0] * v[0] + v[1] * v[1]) + (v[2] * v[2] + v[3] * v[3]);
    }
    __device__ __forceinline__ void put_ssq(int row, int slot, float s) const { ssqp[(size_t)row * 16 + slot] = s; }
    __device__ __forceinline__ void fast(const f32x4 (&acc)[2][2][4][2], const pg8::Unit& u, int wr, int wc, int fr, int fq, RsCache& rsc) const {
        asm volatile("" : "+v"(fr), "+v"(fq));
        const int row0 = u.pm * 256 + wr * 64 + fr, cb = u.pn * 256 + wc * 32 + 8 * fq;
#pragma unroll
        for (int ai = 0; ai < 2; ++ai)
#pragma unroll
            for (int m = 0; m < 4; ++m) { const int row = row0 + ai * 128 + m * 16; const float s = row_scale(row); bf16_t* rowp = F + (size_t)row * ldf + cb; float q = 0.f;
#pragma unroll
                for (int bj = 0; bj < 2; ++bj) { const f32x4 v0 = acc[ai][bj][m][0] * s, v1 = acc[ai][bj][m][1] * s;
                    u32x4 w; w.x = pk2(v0[0], v0[1]); w.y = pk2(v0[2], v0[3]); w.z = pk2(v1[0], v1[1]); w.w = pk2(v1[2], v1[3]);
                    *(u32x4*)(rowp + bj * 128) = w;
                    q += ((v0[0] * v0[0] + v0[1] * v0[1]) + (v0[2] * v0[2] + v0[3] * v0[3])) + ((v1[0] * v1[0] + v1[1] * v1[1]) + (v1[2] * v1[2] + v1[3] * v1[3])); }
                q += __shfl_xor(q, 16); q += __shfl_xor(q, 32);
                if (fq == 0) ssqp[(size_t)row * 16 + u.pn * 4 + wc] = q;
                asm volatile("" ::: "memory"); }
    }
};


struct EpiOutFused {
    static constexpr bool AFTER_DRAIN = true;
    const float* ssq_in; float inv_k;
    bf16_t* XB; float* outf; const float* gain; float* ssqx; float* xch; unsigned* cnt; unsigned target;
    __device__ __forceinline__ void fast(const f32x4 (&)[2][2][4][2], const pg8::Unit&, int, int, int, int, RsCache&) const {}
    __device__ __forceinline__ void fused(f32x4 (&acc)[2][2][4][2], const pg8::Unit& u, int wr, int wc, int fr, int fq, LAS unsigned char* lds, int wid, int lane) const {
        LAS float* P = (LAS float*)lds;
        LAS float* S = (LAS float*)(lds + 4096);
        const int tid = wid * 64 + lane;
        LAS float* S0 = (LAS float*)(lds + 8192);
        if (ssq_in) {
            const int r = tid & 255, hf = tid >> 8; const float* p = ssq_in + (size_t)(hf * 64) * M_ + (size_t)u.pm * 256 + r; float t = 0.f;
#pragma unroll 16
            for (int k = 0; k < 64; ++k) t += p[(size_t)k * M_];
            S0[hf * 256 + r] = t;
            asm volatile("s_waitcnt lgkmcnt(0)" ::: "memory"); __builtin_amdgcn_s_barrier(); asm volatile("" ::: "memory");
        }
#pragma unroll
        for (int ai = 0; ai < 2; ++ai)
#pragma unroll
            for (int m = 0; m < 4; ++m) {
                const int rl = ai * 128 + wr * 64 + m * 16 + fr; const int row = u.pm * 256 + rl;
                const float s = ssq_in ? rsqrtf((S0[rl] + S0[256 + rl]) * inv_k + EPS_) : 1.0f; (void)row;
                float q = 0.f;
#pragma unroll
                for (int bj = 0; bj < 2; ++bj)
#pragma unroll
                    for (int n = 0; n < 2; ++n) { f32x4 v = acc[ai][bj][m][n] * s; acc[ai][bj][m][n] = v; q += (v[0] * v[0] + v[1] * v[1]) + (v[2] * v[2] + v[3] * v[3]); }
                q += __shfl_xor(q, 16); q += __shfl_xor(q, 32);
                if (fq == 0) P[rl * 4 + wc] = q;
            }
        asm volatile("s_waitcnt lgkmcnt(0)" ::: "memory"); __builtin_amdgcn_s_barrier(); asm volatile("" ::: "memory");
        if (tid < 256) {
            const f32x4 p = *(const LAS f32x4*)(P + tid * 4);
            __hip_atomic_store(xch + ((size_t)u.pm * 4 + u.pn) * 256 + tid, (p[0] + p[1]) + (p[2] + p[3]), __ATOMIC_RELAXED, __HIP_MEMORY_SCOPE_AGENT);
        }
        asm volatile("s_waitcnt vmcnt(0)" ::: "memory");
        if (wid < 4 && lane == 0) __hip_atomic_fetch_add(cnt + 64 * u.pm, 1u, __ATOMIC_RELAXED, __HIP_MEMORY_SCOPE_AGENT);
        const int cb = u.pn * 256 + wc * 32 + 8 * fq;
        uint4 xold[4][2];
#pragma unroll
        for (int m = 0; m < 4; ++m)
#pragma unroll
            for (int bj = 0; bj < 2; ++bj) xold[m][bj] = *(const uint4*)(XB + (size_t)(u.pm * 256 + wr * 64 + m * 16 + fr) * 1024 + cb + bj * 128);
        if (wid == 0) {
            unsigned sp = 0;
            while ((unsigned)__builtin_amdgcn_readfirstlane(__hip_atomic_load(cnt + 64 * u.pm, __ATOMIC_RELAXED, __HIP_MEMORY_SCOPE_AGENT)) < target) { __builtin_amdgcn_s_sleep(1); if (++sp > (1u << 22)) break; }
        }
        asm volatile("s_waitcnt lgkmcnt(0)" ::: "memory"); __builtin_amdgcn_s_barrier(); asm volatile("" ::: "memory");
        if (tid < 256) {
            float t = 0.f;
#pragma unroll
            for (int k = 0; k < 4; ++k) t += __hip_atomic_load(xch + ((size_t)u.pm * 4 + k) * 256 + tid, __ATOMIC_RELAXED, __HIP_MEMORY_SCOPE_AGENT);
            S[tid] = rsqrtf(t * (1.0f / 1024.f) + EPS_);
        }
        asm volatile("s_waitcnt vmcnt(0) lgkmcnt(0)" ::: "memory"); __builtin_amdgcn_s_barrier(); asm volatile("" ::: "memory");
        f32x4 g4[2][2];
#pragma unroll
        for (int bj = 0; bj < 2; ++bj) { g4[bj][0] = *(const f32x4*)(gain + cb + bj * 128); g4[bj][1] = *(const f32x4*)(gain + cb + bj * 128 + 4); }
#pragma unroll
        for (int ai = 0; ai < 2; ++ai) {
            if (ai == 1) {
#pragma unroll
                for (int m = 0; m < 4; ++m)
#pragma unroll
                    for (int bj = 0; bj < 2; ++bj) xold[m][bj] = *(const uint4*)(XB + (size_t)(u.pm * 256 + 128 + wr * 64 + m * 16 + fr) * 1024 + cb + bj * 128);
            }
#pragma unroll
            for (int m = 0; m < 4; ++m) {
                const int rl = ai * 128 + wr * 64 + m * 16 + fr; const size_t off = (size_t)(u.pm * 256 + rl) * 1024 + cb;
                const float rsf = S[rl]; float q = 0.f;
#pragma unroll
                for (int bj = 0; bj < 2; ++bj) {
                    float xo[8]; unpack8(xold[m][bj], xo);
                    f32x4 v0 = acc[ai][bj][m][0] * rsf * g4[bj][0], v1 = acc[ai][bj][m][1] * rsf * g4[bj][1];
                    float xn[8];
#pragma unroll
                    for (int e = 0; e < 4; ++e) { xn[e] = xo[e] + v0[e]; xn[4 + e] = xo[4 + e] + v1[e]; }
                    if (outf) { *(f32x4*)(outf + off + bj * 128) = (f32x4){xn[0], xn[1], xn[2], xn[3]}; *(f32x4*)(outf + off + bj * 128 + 4) = (f32x4){xn[4], xn[5], xn[6], xn[7]}; }
                    else { *(uint4*)(XB + off + bj * 128) = pack8(xn); }
#pragma unroll
                    for (int e = 0; e < 8; ++e) q += xn[e] * xn[e];
                }
                q += __shfl_xor(q, 16); q += __shfl_xor(q, 32);
                if (fq == 0) P[rl * 4 + wc] = q;
            }
            asm volatile("" ::: "memory");
        }
        asm volatile("s_waitcnt lgkmcnt(0)" ::: "memory"); __builtin_amdgcn_s_barrier(); asm volatile("" ::: "memory");
        if (tid < 256 && !outf) { const f32x4 p = *(const LAS f32x4*)(P + tid * 4); ssqx[(size_t)(u.pm * 256 + tid) * 4 + u.pn] = (p[0] + p[1]) + (p[2] + p[3]); }
    }
};

template <int CTRL> __device__ __forceinline__ float dppz(float x) { return __builtin_bit_cast(float, __builtin_amdgcn_update_dpp(0, __builtin_bit_cast(int, x), CTRL, 0xf, 0xf, true)); }
struct EpiFfnUp {
    static constexpr bool AFTER_DRAIN = false;
    bf16_t* act; const float* rs; const float* cw; const float* cb; bf16_t* sideg; bf16_t* sidev;
    __device__ __forceinline__ void fast(const f32x4 (&acc)[2][2][4][2], const pg8::Unit& u, int wr, int wc, int fr, int fq, RsCache& rsc) const {
        asm volatile("" : "+v"(fr), "+v"(fq));
        rs_cache_fill(rsc, rs, u.pm, wr, fq * 16 + fr);
        typedef float f32x2 __attribute__((ext_vector_type(2)));
        const int ch = u.pn * 128 + wc * 32 + 8 * fq;
        f32x2 w0[4], w1[4], w2[4], bb[4];
#pragma unroll
        for (int h = 0; h < 2; ++h) { const f32x4 t0 = *(const f32x4*)(cw + ch + 4 * h), t1 = *(const f32x4*)(cw + FH + ch + 4 * h), t2 = *(const f32x4*)(cw + 2 * FH + ch + 4 * h), t3 = *(const f32x4*)(cb + ch + 4 * h);
            w0[2 * h] = (f32x2){t0[0], t0[1]}; w0[2 * h + 1] = (f32x2){t0[2], t0[3]}; w1[2 * h] = (f32x2){t1[0], t1[1]}; w1[2 * h + 1] = (f32x2){t1[2], t1[3]};
            w2[2 * h] = (f32x2){t2[0], t2[1]}; w2[2 * h + 1] = (f32x2){t2[2], t2[3]}; bb[2 * h] = (f32x2){t3[0], t3[1]}; bb[2 * h + 1] = (f32x2){t3[2], t3[3]}; }
#pragma unroll
        for (int ai = 0; ai < 2; ++ai) {
            const int rowb = u.pm * 256 + ai * 128 + wr * 64, blk = rowb >> 6;
            f32x2 gp[4];
#pragma unroll
            for (int m = 0; m < 4; ++m) {
                const int row = rowb + m * 16 + fr; const float s = rsc.tab[ai * 64 + m * 16 + fr]; const f32x2 s2 = (f32x2){s, s};
                f32x2 g[4], o[4], v[4];
#pragma unroll
                for (int cp = 0; cp < 4; ++cp) { const int n = cp >> 1, e0 = (cp & 1) * 2;
                    g[cp] = (f32x2){acc[ai][0][m][n][e0], acc[ai][0][m][n][e0 + 1]} * s2; v[cp] = (f32x2){acc[ai][1][m][n][e0], acc[ai][1][m][n][e0 + 1]} * s2; }
#pragma unroll
                for (int cp = 0; cp < 4; ++cp) {
                    f32x2 p1 = (f32x2){dppz<0x111>(g[cp].x), dppz<0x111>(g[cp].y)}, p2 = (f32x2){dppz<0x112>(g[cp].x), dppz<0x112>(g[cp].y)};
                    if (m > 0) { p1 += (f32x2){dppz<0x10F>(gp[cp].x), dppz<0x10F>(gp[cp].y)}; p2 += (f32x2){dppz<0x10E>(gp[cp].x), dppz<0x10E>(gp[cp].y)}; }
                    const f32x2 gv = bb[cp] + w0[cp] * p2 + w1[cp] * p1 + w2[cp] * g[cp];
                    const f32x2 ea = gv * (-1.44269504089f);
                    f32x2 ex; ex.x = __builtin_amdgcn_exp2f(ea.x); ex.y = __builtin_amdgcn_exp2f(ea.y);
                    const f32x2 dn = ex + 1.0f;
                    f32x2 rc; rc.x = __builtin_amdgcn_rcpf(dn.x); rc.y = __builtin_amdgcn_rcpf(dn.y);
                    o[cp] = (gv * rc) * v[cp];
                }
                if (m > 0 || fr >= 2) { uint4 w; w.x = pk2(o[0].x, o[0].y); w.y = pk2(o[1].x, o[1].y); w.z = pk2(o[2].x, o[2].y); w.w = pk2(o[3].x, o[3].y); *(uint4*)(act + (size_t)row * FH + ch) = w; }
                if (m == 0 && fr < 2) { uint4 w; w.x = pk2(g[0].x, g[0].y); w.y = pk2(g[1].x, g[1].y); w.z = pk2(g[2].x, g[2].y); w.w = pk2(g[3].x, g[3].y); *(uint4*)(sideg + ((size_t)blk * 4 + fr) * FH + ch) = w;
                    uint4 q; q.x = pk2(v[0].x, v[0].y); q.y = pk2(v[1].x, v[1].y); q.z = pk2(v[2].x, v[2].y); q.w = pk2(v[3].x, v[3].y); *(uint4*)(sidev + ((size_t)blk * 2 + fr) * FH + ch) = q; }
                if (m == 3 && fr >= 14) { uint4 w; w.x = pk2(g[0].x, g[0].y); w.y = pk2(g[1].x, g[1].y); w.z = pk2(g[2].x, g[2].y); w.w = pk2(g[3].x, g[3].y); *(uint4*)(sideg + ((size_t)blk * 4 + 2 + (fr - 14)) * FH + ch) = w; }
#pragma unroll
                for (int cp = 0; cp < 4; ++cp) gp[cp] = g[cp];
                asm volatile("" ::: "memory");
            }
        }
    }
};
__device__ __forceinline__ void phase_ffn_fixup(const Args& a, int li, const pg8::StaticOrder& S) {
    bf16_t* act = (bf16_t*)(a.ws + WS_BIG); const bf16_t* sideg = (const bf16_t*)(a.ws + WS_SIDEG); const bf16_t* sidev = (const bf16_t*)(a.ws + WS_SIDEV);
    const float* cw = a.in[17] + (size_t)li * 3 * FH; const float* cb = a.in[18] + (size_t)li * FH;
    const int tid = opaque_tid();
    pg8::Unit u;
    for (int ui = 0; S.next(ui, u); ++ui) {
        if (tid < FH / 8) {
            const int ch = tid * 8;
            float w0[8], w1[8], w2[8], bb[8];
#pragma unroll
            for (int h = 0; h < 2; ++h) { const f32x4 t0 = *(const f32x4*)(cw + ch + 4 * h), t1 = *(const f32x4*)(cw + FH + ch + 4 * h), t2 = *(const f32x4*)(cw + 2 * FH + ch + 4 * h), t3 = *(const f32x4*)(cb + ch + 4 * h);
#pragma unroll
                for (int e = 0; e < 4; ++e) { w0[4 * h + e] = t0[e]; w1[4 * h + e] = t1[e]; w2[4 * h + e] = t2[e]; bb[4 * h + e] = t3[e]; } }
            uint4 pg2[4], pg3[4], og0[4], og1[4], ov0[4], ov1[4];
#pragma unroll
            for (int k = 0; k < 4; ++k) {
                const int blk = u.pm * 4 + k; const bool bstart = (blk & 63) == 0;
                const int pb = bstart ? blk : blk - 1;
                pg2[k] = *(const uint4*)(sideg + ((size_t)pb * 4 + 2) * FH + ch); pg3[k] = *(const uint4*)(sideg + ((size_t)pb * 4 + 3) * FH + ch);
                if (bstart) { pg2[k] = make_uint4(0, 0, 0, 0); pg3[k] = make_uint4(0, 0, 0, 0); }
                og0[k] = *(const uint4*)(sideg + ((size_t)blk * 4 + 0) * FH + ch); og1[k] = *(const uint4*)(sideg + ((size_t)blk * 4 + 1) * FH + ch);
                ov0[k] = *(const uint4*)(sidev + ((size_t)blk * 2 + 0) * FH + ch); ov1[k] = *(const uint4*)(sidev + ((size_t)blk * 2 + 1) * FH + ch);
            }
#pragma unroll
            for (int k = 0; k < 4; ++k) {
                const int blk = u.pm * 4 + k;
                float gm2[8], gm1[8], g0[8], g1[8], v0[8], v1[8], o0[8], o1[8];
                unpack8(pg2[k], gm2); unpack8(pg3[k], gm1); unpack8(og0[k], g0); unpack8(og1[k], g1); unpack8(ov0[k], v0); unpack8(ov1[k], v1);
#pragma unroll
                for (int e = 0; e < 8; ++e) {
                    o0[e] = silu_f(bb[e] + w0[e] * gm2[e] + w1[e] * gm1[e] + w2[e] * g0[e]) * v0[e];
                    o1[e] = silu_f(bb[e] + w0[e] * gm1[e] + w1[e] * g0[e] + w2[e] * g1[e]) * v1[e];
                }
                *(uint4*)(act + (size_t)(blk * 64) * FH + ch) = pack8(o0); *(uint4*)(act + (size_t)(blk * 64 + 1) * FH + ch) = pack8(o1);
            }
        }
    }
    asm volatile("s_waitcnt vmcnt(0)" ::: "memory");
    __syncthreads();
}

__device__ __forceinline__ void p0_transpose_item(const float* W, int K, int N, bf16_t* WT, const float* ks, float* scr, int item, int lane, int ilv) {
    const int nblk = N / 32, kb = item / nblk, nb = item % nblk, k0 = 64 * kb, n0 = 32 * nb;
    const int d0 = ilv == 0 ? n0 : ilv == 1 ? (n0 < FH ? 256 * (n0 / 128) + (n0 % 128) : 256 * ((n0 - FH) / 128) + 128 + ((n0 - FH) % 128))
                 : (n0 < 1024 ? 2048 + n0 : n0 < 2048 ? 256 * ((n0 - 1024) / 128) + ((n0 - 1024) % 128) : 256 * ((n0 - 2048) / 128) + 128 + ((n0 - 2048) % 128));
#pragma unroll 8
    for (int i = 0; i < 32; ++i) { const int kk = 2 * i + (lane >> 5); scr[kk * 33 + (lane & 31)] = W[(size_t)(k0 + kk) * N + n0 + (lane & 31)]; }
    __builtin_amdgcn_fence(__ATOMIC_RELEASE, "wavefront"); __builtin_amdgcn_wave_barrier();
    const int c = lane & 7;
    float sc[8];
#pragma unroll
    for (int q = 0; q < 8; ++q) sc[q] = ks ? ks[k0 + 8 * c + q] : 1.0f;
#pragma unroll
    for (int jj = 0; jj < 4; ++jj) { const int n = (lane >> 3) + 8 * jj; const float* s = scr + (8 * c) * 33 + n;
        uint4 o; o.x = pk2(s[0 * 33] * sc[0], s[1 * 33] * sc[1]); o.y = pk2(s[2 * 33] * sc[2], s[3 * 33] * sc[3]); o.z = pk2(s[4 * 33] * sc[4], s[5 * 33] * sc[5]); o.w = pk2(s[6 * 33] * sc[6], s[7 * 33] * sc[7]);
        *(uint4*)(WT + (size_t)(d0 + n) * K + k0 + 8 * c) = o; }
    __builtin_amdgcn_fence(__ATOMIC_RELEASE, "wavefront"); __builtin_amdgcn_wave_barrier();
}

__device__ __forceinline__ void convert_weights(const Args& a, float* ldsf, unsigned mask, int wb, int nwb) {
    const int tid = opaque_tid(), lane = tid & 63, wave = tid >> 6;
    const int gw = wb * NWAVES + wave, NGW = nwb * NWAVES;
    float* scr = ldsf + wave * 2304;
    unsigned char* ws = a.ws;
    for (int q = 0; q < 16; ++q) {
        const int mi = (q + 1) & 15;
        if (!((mask >> mi) & 1u)) continue;
        const float* W; bf16_t* WT; const float* ks; int K, N;
        if (mi < 2) { const int j = mi; W = a.in[5] + (size_t)j * 1024 * SSD_IN_N; K = 1024; N = SSD_IN_N; WT = (bf16_t*)(ws + WS_SSDIN + j * SZ_SSDIN1); ks = a.in[1] + (2 * j) * 1024; }
        else if (mi < 4) { const int j = mi - 2; W = a.in[12] + (size_t)j * 2048 * 1024; K = 2048; N = 1024; WT = (bf16_t*)(ws + WS_SSDOUT + j * SZ_SSDOUT1); ks = a.in[11] + j * 2048; }
        else if (mi < 6) { const int j = mi - 4; W = a.in[13] + (size_t)j * 1024 * 3072; K = 1024; N = 3072; WT = (bf16_t*)(ws + WS_SCIN + j * SZ_SCIN1); ks = a.in[1] + (2 * j + 1) * 1024; }
        else if (mi < 8) { const int j = mi - 6; W = a.in[15] + (size_t)j * 1024 * 1024; K = 1024; N = 1024; WT = (bf16_t*)(ws + WS_SCOUT + j * SZ_SCOUT1); ks = nullptr; }
        else if (mi < 12) { const int i = mi - 8; W = a.in[16] + (size_t)i * 1024 * FH2; K = 1024; N = FH2; WT = (bf16_t*)(ws + WS_FUP + i * SZ_FUP1); ks = a.in[3] + i * 1024; }
        else { const int i = mi - 12; W = a.in[19] + (size_t)i * FH * 1024; K = FH; N = 1024; WT = (bf16_t*)(ws + WS_FDN + i * SZ_FDN1); ks = nullptr; }
        const int nitems = (K / 64) * (N / 32);
        for (int it = gw; it < nitems; it += NGW) p0_transpose_item(W, K, N, WT, ks, scr, it, lane, (mi >= 8 && mi < 12) ? 1 : ((mi >= 4 && mi < 6) ? 2 : 0));
    }
}
__device__ __forceinline__ void phase_prep(const Args& a, float* ldsf) {
    const int tid = opaque_tid(), lane = tid & 63, wave = tid >> 6;
    const int gw = blockIdx.x * NWAVES + wave, NGW = gridDim.x * NWAVES;
    unsigned char* ws = a.ws;
    convert_weights(a, ldsf, CONV_PREP_MASK, (int)blockIdx.x, (int)gridDim.x);
    {
        const int gt = blockIdx.x * NTHREADS + tid, NGT = gridDim.x * NTHREADS;
        const int per = (SSD_IN_PAD - SSD_IN_N) * 1024 * 2 / 16;
        for (int i = gt; i < 2 * per; i += NGT) { const int j = i / per, r = i % per; ((uint4*)(ws + WS_SSDIN + j * SZ_SSDIN1 + (size_t)SSD_IN_N * 1024 * 2))[r] = make_uint4(0, 0, 0, 0); }
        for (int i = gt; i < 2 * M_; i += NGT) ((unsigned long long*)(ws + WS_SSQY))[i] = 0ull;
    }
    const float* x = a.in[0]; bf16_t* XB = (bf16_t*)(ws + WS_XB); float* RSX = (float*)(ws + WS_RSX);
    for (int row = gw; row < M_; row += NGW) {
        float s2 = 0.f;
#pragma unroll
        for (int jj = 0; jj < 4; ++jj) {
            const size_t idx = (size_t)row * 1024 + 256 * jj + 4 * lane;
            const f32x4 v = *(const f32x4*)(x + idx);
            u32x2 w; w.x = pk2(v[0], v[1]); w.y = pk2(v[2], v[3]); *(u32x2*)(XB + idx) = w;
            s2 += (v[0] * v[0] + v[1] * v[1]) + (v[2] * v[2] + v[3] * v[3]);
        }
        s2 = wave_sum(s2);
        if (lane == 0) *(f32x4*)(RSX + (size_t)row * 4) = (f32x4){s2, 0.f, 0.f, 0.f};
    }
}

__device__ __forceinline__ void phase_resid(const Args& a, const float* gain, bool last, const bf16_t* F, int ldf) {
    const int tid = opaque_tid(), lane = tid & 63, wave = tid >> 6;
    const int gw = blockIdx.x * NWAVES + wave, NGW = gridDim.x * NWAVES;
    bf16_t* XB = (bf16_t*)(a.ws + WS_XB); float* RSX = (float*)(a.ws + WS_RSX); const float* ssqp = (const float*)(a.ws + WS_SSQP);
    f32x4 g4[4];
#pragma unroll
    for (int jj = 0; jj < 4; ++jj) g4[jj] = *(const f32x4*)(gain + 256 * jj + 4 * lane);
    for (int row = gw; row < M_; row += NGW) {
        float p = lane < 16 ? ssqp[(size_t)row * 16 + lane] : 0.f;
        p = wave_sum(p);
        const float rs = rsqrtf(p * (1.0f / 1024.f) + EPS_);
        float s2 = 0.f;
#pragma unroll
        for (int jj = 0; jj < 4; ++jj) {
            const size_t idx = (size_t)row * 1024 + 256 * jj + 4 * lane;
            const u32x2 xw = *(const u32x2*)(XB + idx);
            const u32x2 fw = *(const u32x2*)(F + (size_t)row * ldf + 256 * jj + 4 * lane);
            f32x4 v;
            v[0] = bf_lo(xw.x) + bf_lo(fw.x) * rs * g4[jj][0]; v[1] = bf_hi(xw.x) + bf_hi(fw.x) * rs * g4[jj][1]; v[2] = bf_lo(xw.y) + bf_lo(fw.y) * rs * g4[jj][2]; v[3] = bf_hi(xw.y) + bf_hi(fw.y) * rs * g4[jj][3];
            if (last) { *(f32x4*)(a.out + idx) = v; }
            else {
                u32x2 w; w.x = pk2(v[0], v[1]); w.y = pk2(v[2], v[3]); *(u32x2*)(XB + idx) = w;
                s2 += (v[0] * v[0] + v[1] * v[1]) + (v[2] * v[2] + v[3] * v[3]);
            }
        }
        if (!last) { s2 = wave_sum(s2); if (lane == 0) *(f32x4*)(RSX + (size_t)row * 4) = (f32x4){s2, 0.f, 0.f, 0.f}; }
    }
}

__device__ __forceinline__ void phase_ffn_conv(const Args& a, int li) {
    bf16_t* BIG = (bf16_t*)(a.ws + WS_BIG);
    const float* cw = a.in[17] + (size_t)li * 3 * FH; const float* cb = a.in[18] + (size_t)li * FH;
    const int gt = blockIdx.x * NTHREADS + opaque_tid(), NGT = gridDim.x * NTHREADS;
    constexpr int C8 = FH / 8, RUN = 16, NITEMS = (M_ / RUN) * C8;
    for (int it = gt; it < NITEMS; it += NGT) {
        const int c8 = it % C8, rb = it / C8, c0 = c8 * 8, row0 = rb * RUN;
        float w0[8], w1[8], w2[8], bb[8];
#pragma unroll
        for (int h = 0; h < 2; ++h) { const f32x4 t0 = *(const f32x4*)(cw + c0 + 4 * h), t1 = *(const f32x4*)(cw + FH + c0 + 4 * h), t2 = *(const f32x4*)(cw + 2 * FH + c0 + 4 * h), t3 = *(const f32x4*)(cb + c0 + 4 * h);
#pragma unroll
            for (int e = 0; e < 4; ++e) { w0[4 * h + e] = t0[e]; w1[4 * h + e] = t1[e]; w2[4 * h + e] = t2[e]; bb[4 * h + e] = t3[e]; } }
        float g0[8], g1[8];
        if ((row0 & (SEQ_ - 1)) == 0) {
#pragma unroll
            for (int e = 0; e < 8; ++e) { g0[e] = 0.f; g1[e] = 0.f; }
        } else {
            unpack8(*(const uint4*)(BIG + (size_t)(row0 - 2) * FH2 + c0), g0); unpack8(*(const uint4*)(BIG + (size_t)(row0 - 1) * FH2 + c0), g1);
        }
#pragma unroll 4
        for (int r = 0; r < RUN; ++r) {
            bf16_t* p = BIG + (size_t)(row0 + r) * FH2 + c0;
            float gc[8], vv[8], o[8];
            unpack8(*(const uint4*)p, gc); unpack8(*(const uint4*)(p + FH), vv);
#pragma unroll
            for (int e = 0; e < 8; ++e) { const float gv = bb[e] + w0[e] * g0[e] + w1[e] * g1[e] + w2[e] * gc[e]; o[e] = silu_f(gv) * vv[e]; g0[e] = g1[e]; g1[e] = gc[e]; }
            *(uint4*)(p + FH) = pack8(o);
        }
    }
}

__device__ __forceinline__ void phase_sc_conv(const Args& a, int j) {
    bf16_t* BIG = (bf16_t*)(a.ws + WS_BIG);
    const float* cw = a.in[14] + (size_t)j * 3 * 1024;
    const int gt = blockIdx.x * NTHREADS + opaque_tid(), NGT = gridDim.x * NTHREADS;
    constexpr int C8 = 1024 / 8, RUN = 16, NITEMS = (M_ / RUN) * C8, LD = 2048;
    for (int it = gt; it < NITEMS; it += NGT) {
        const int c8 = it % C8, rb = it / C8, c0 = c8 * 8, row0 = rb * RUN;
        float w0[8], w1[8], w2[8];
#pragma unroll
        for (int h = 0; h < 2; ++h) { const f32x4 t0 = *(const f32x4*)(cw + c0 + 4 * h), t1 = *(const f32x4*)(cw + 1024 + c0 + 4 * h), t2 = *(const f32x4*)(cw + 2048 + c0 + 4 * h);
#pragma unroll
            for (int e = 0; e < 4; ++e) { w0[4 * h + e] = t0[e]; w1[4 * h + e] = t1[e]; w2[4 * h + e] = t2[e]; } }
        float g0[8], g1[8];
        if ((row0 & (SEQ_ - 1)) == 0) {
#pragma unroll
            for (int e = 0; e < 8; ++e) { g0[e] = 0.f; g1[e] = 0.f; }
        } else {
            unpack8(*(const uint4*)(BIG + (size_t)(row0 - 2) * LD + 1024 + c0), g0); unpack8(*(const uint4*)(BIG + (size_t)(row0 - 1) * LD + 1024 + c0), g1);
        }
#pragma unroll 4
        for (int r = 0; r < RUN; ++r) {
            bf16_t* p = BIG + (size_t)(row0 + r) * LD + c0;
            float gb[8], cur[8], o[8];
            unpack8(*(const uint4*)p, gb); unpack8(*(const uint4*)(p + 1024), cur);
#pragma unroll
            for (int e = 0; e < 8; ++e) { o[e] = gb[e] * (w0[e] * g0[e] + w1[e] * g1[e] + w2[e] * cur[e]); g0[e] = g1[e]; g1[e] = cur[e]; }
            *(uint4*)p = pack8(o);
        }
    }
}

__device__ __forceinline__ void phase_ssd_conv(const Args& a, int j) {
    bf16_t* BIG = (bf16_t*)(a.ws + WS_BIG); const bf16_t* HALO = (const bf16_t*)(a.ws + WS_HALO);
    const float* cw = a.in[6] + (size_t)j * 4 * 4096; const float* cb = a.in[7] + (size_t)j * 4096;
    const int tid = opaque_tid(), lane = tid & 63, wave = tid >> 6;
    const int gw = blockIdx.x * NWAVES + wave, NGW = gridDim.x * NWAVES;
    for (int w = gw; w < 2048; w += NGW) {
        const int cg8 = w & 7, bs = w >> 3, c0 = cg8 * 512 + lane * 8;
        float wt[4][8], bb[8];
#pragma unroll
        for (int h = 0; h < 2; ++h) {
#pragma unroll
            for (int k = 0; k < 4; ++k) { const f32x4 t = *(const f32x4*)(cw + k * 4096 + c0 + 4 * h);
#pragma unroll
                for (int e = 0; e < 4; ++e) wt[k][4 * h + e] = t[e]; }
            const f32x4 t = *(const f32x4*)(cb + c0 + 4 * h);
#pragma unroll
            for (int e = 0; e < 4; ++e) bb[4 * h + e] = t[e];
        }
        float h0[8], h1[8], h2[8];
        if ((bs & 63) == 0) {
#pragma unroll
            for (int e = 0; e < 8; ++e) { h0[e] = 0.f; h1[e] = 0.f; h2[e] = 0.f; }
        } else {
            const bf16_t* hp = HALO + (size_t)(bs - 1) * 3 * 4096 + c0;
            unpack8(*(const uint4*)hp, h0); unpack8(*(const uint4*)(hp + 4096), h1); unpack8(*(const uint4*)(hp + 8192), h2);
        }
        bf16_t* p = BIG + (size_t)bs * 64 * BIGW + DI_ + c0;
#pragma unroll 4
        for (int t = 0; t < 64; ++t) {
            float cur[8], o[8];
            unpack8(*(const uint4*)(p + (size_t)t * BIGW), cur);
#pragma unroll
            for (int e = 0; e < 8; ++e) { const float v = bb[e] + wt[0][e] * h0[e] + wt[1][e] * h1[e] + wt[2][e] * h2[e] + wt[3][e] * cur[e]; o[e] = silu_f(v); h0[e] = h1[e]; h1[e] = h2[e]; h2[e] = cur[e]; }
            *(uint4*)(p + (size_t)t * BIGW) = pack8(o);
        }
    }
}

__device__ __forceinline__ void ssd_dt_job(const Args& a, int j) {
    const bf16_t* XB = (const bf16_t*)(a.ws + WS_XB); const bf16_t* Wdt = (const bf16_t*)(a.ws + WS_SSDIN + j * SZ_SSDIN1) + (size_t)BIGW * 1024;
    const float* RSX = (const float*)(a.ws + WS_RSX); float* DT = (float*)(a.ws + WS_DT); const float* dt_bias = a.in[8] + j * 32;
    const int tid = opaque_tid(), lane = tid & 63, wave = tid >> 6, c16 = lane & 15, q4 = lane >> 4;
    const int gw = blockIdx.x * NWAVES + wave, NGW = gridDim.x * NWAVES;
    for (int rg = gw; rg < M_ / 16; rg += NGW) {
        const int row0 = rg * 16;
        f32x4 d0 = (f32x4){0.f, 0.f, 0.f, 0.f}, d1 = (f32x4){0.f, 0.f, 0.f, 0.f};
        const bf16_t* xp = XB + (size_t)(row0 + c16) * 1024 + q4 * 8; const bf16_t* w0p = Wdt + (size_t)c16 * 1024 + q4 * 8; const bf16_t* w1p = w0p + 16 * 1024;
#pragma unroll 4
        for (int k0 = 0; k0 < 1024; k0 += 32) {
            const bf16x8 xf = *(const bf16x8*)(xp + k0), wf0 = *(const bf16x8*)(w0p + k0), wf1 = *(const bf16x8*)(w1p + k0);
            d0 = __builtin_amdgcn_mfma_f32_16x16x32_bf16(wf0, xf, d0, 0, 0, 0);
            d1 = __builtin_amdgcn_mfma_f32_16x16x32_bf16(wf1, xf, d1, 0, 0, 0);
        }
        const int row = row0 + c16; const float s = rsx(RSX, row);
        const f32x4 b0 = *(const f32x4*)(dt_bias + 4 * q4), b1 = *(const f32x4*)(dt_bias + 16 + 4 * q4);
        f32x4 o0, o1;
#pragma unroll
        for (int e = 0; e < 4; ++e) { o0[e] = softplus_f(d0[e] * s + b0[e]); o1[e] = softplus_f(d1[e] * s + b1[e]); }
        *(f32x4*)(DT + (size_t)row * 32 + 4 * q4) = o0; *(f32x4*)(DT + (size_t)row * 32 + 16 + 4 * q4) = o1;
    }
}

__device__ __forceinline__ void phase_ssd_conv_dt(const Args& a, int j) {
    const int tid = opaque_tid(), lane = tid & 63, wave = tid >> 6;
    const int gw = blockIdx.x * NWAVES + wave, NGW = gridDim.x * NWAVES;
    if (NGW != 2048) { phase_ssd_conv(a, j); ssd_dt_job(a, j); return; }
    bf16_t* BIG = (bf16_t*)(a.ws + WS_BIG); const bf16_t* HALO = (const bf16_t*)(a.ws + WS_HALO);
    const float* cw = a.in[6] + (size_t)j * 4 * 4096; const float* cb = a.in[7] + (size_t)j * 4096;
    const int cg8 = gw & 7, bs = gw >> 3, c0 = cg8 * 512 + lane * 8;
    float wt[4][8], bb[8];
#pragma unroll
    for (int h = 0; h < 2; ++h) {
#pragma unroll
        for (int k = 0; k < 4; ++k) { const f32x4 t = *(const f32x4*)(cw + k * 4096 + c0 + 4 * h);
#pragma unroll
            for (int e = 0; e < 4; ++e) wt[k][4 * h + e] = t[e]; }
        const f32x4 t = *(const f32x4*)(cb + c0 + 4 * h);
#pragma unroll
        for (int e = 0; e < 4; ++e) bb[4 * h + e] = t[e];
    }
    float h0[8], h1[8], h2[8];
    if ((bs & 63) == 0) {
#pragma unroll
        for (int e = 0; e < 8; ++e) { h0[e] = 0.f; h1[e] = 0.f; h2[e] = 0.f; }
    } else {
        const bf16_t* hp = HALO + (size_t)(bs - 1) * 3 * 4096 + c0;
        unpack8(*(const uint4*)hp, h0); unpack8(*(const uint4*)(hp + 4096), h1); unpack8(*(const uint4*)(hp + 8192), h2);
    }
    bf16_t* p = BIG + (size_t)bs * 64 * BIGW + DI_ + c0;
    const bool has_dt = __builtin_amdgcn_readfirstlane(gw) < M_ / 16;
    const int c16 = lane & 15, q4 = lane >> 4, drow0 = (has_dt ? gw : 0) * 16;
    const bf16_t* XB = (const bf16_t*)(a.ws + WS_XB); const bf16_t* Wdt = (const bf16_t*)(a.ws + WS_SSDIN + j * SZ_SSDIN1) + (size_t)BIGW * 1024;
    const bf16_t* xp = XB + (size_t)(drow0 + c16) * 1024 + q4 * 8; const bf16_t* w0p = Wdt + (size_t)c16 * 1024 + q4 * 8; const bf16_t* w1p = w0p + 16 * 1024;
    f32x4 d0 = (f32x4){0.f, 0.f, 0.f, 0.f}, d1 = (f32x4){0.f, 0.f, 0.f, 0.f};
#pragma unroll 4
    for (int t = 0; t < 64; ++t) {
        float cur[8], o[8];
        unpack8(*(const uint4*)(p + (size_t)t * BIGW), cur);
        if (has_dt && !(t & 1)) {
            const int k0 = (t >> 1) * 32;
            const bf16x8 xf = *(const bf16x8*)(xp + k0), wf0 = *(const bf16x8*)(w0p + k0), wf1 = *(const bf16x8*)(w1p + k0);
            d0 = __builtin_amdgcn_mfma_f32_16x16x32_bf16(wf0, xf, d0, 0, 0, 0);
            d1 = __builtin_amdgcn_mfma_f32_16x16x32_bf16(wf1, xf, d1, 0, 0, 0);
        }
#pragma unroll
        for (int e = 0; e < 8; ++e) { const float v = bb[e] + wt[0][e] * h0[e] + wt[1][e] * h1[e] + wt[2][e] * h2[e] + wt[3][e] * cur[e]; o[e] = silu_f(v); h0[e] = h1[e]; h1[e] = h2[e]; h2[e] = cur[e]; }
        *(uint4*)(p + (size_t)t * BIGW) = pack8(o);
    }
    if (has_dt) {
        const float* RSX = (const float*)(a.ws + WS_RSX); float* DT = (float*)(a.ws + WS_DT); const float* dt_bias = a.in[8] + j * 32;
        const int row = drow0 + c16; const float s = rsx(RSX, row);
        const f32x4 b0 = *(const f32x4*)(dt_bias + 4 * q4), b1 = *(const f32x4*)(dt_bias + 16 + 4 * q4);
        f32x4 o0, o1;
#pragma unroll
        for (int e = 0; e < 4; ++e) { o0[e] = softplus_f(d0[e] * s + b0[e]); o1[e] = softplus_f(d1[e] * s + b1[e]); }
        *(f32x4*)(DT + (size_t)row * 32 + 4 * q4) = o0; *(f32x4*)(DT + (size_t)row * 32 + 16 + 4 * q4) = o1;
    }
}

__device__ __forceinline__ void phase_ssd_scan_naive(const Args& a, int j) {
    bf16_t* BIG = (bf16_t*)(a.ws + WS_BIG); const float* DT = (const float*)(a.ws + WS_DT); unsigned long long* SSQY = (unsigned long long*)(a.ws + WS_SSQY) + (size_t)j * M_;
    const float* A_log = a.in[9] + j * 32; const float* Dp = a.in[10] + j * 32;
    const int tid = opaque_tid(), lane = tid & 63, p = tid >> 3, q = tid & 7;
    for (int item = blockIdx.x; item < 128; item += gridDim.x) {
        const int b = item >> 5, h = item & 31, g = h >> 2;
        const float Ah = -__expf(A_log[h]), Dh = Dp[h];
        float st[16];
#pragma unroll
        for (int k = 0; k < 16; ++k) st[k] = 0.f;
        for (int t = 0; t < SEQ_; ++t) {
            const size_t row = (size_t)b * SEQ_ + t;
            bf16_t* r = BIG + row * BIGW;
            const float dtv = DT[row * 32 + h];
            const float xv = bf2f(r[DI_ + h * 64 + p]);
            const float zv = bf2f(r[h * 64 + p]);
            float Bf[16], Cf[16];
            unpack8(*(const uint4*)(r + 4096 + g * 128 + q * 16), Bf); unpack8(*(const uint4*)(r + 4096 + g * 128 + q * 16 + 8), Bf + 8);
            unpack8(*(const uint4*)(r + 5120 + g * 128 + q * 16), Cf); unpack8(*(const uint4*)(r + 5120 + g * 128 + q * 16 + 8), Cf + 8);
            const float dA = __expf(dtv * Ah), xdt = xv * dtv;
            float acc = 0.f;
#pragma unroll
            for (int k = 0; k < 16; ++k) { st[k] = st[k] * dA + xdt * Bf[k]; acc += Cf[k] * st[k]; }
            acc += __shfl_xor(acc, 1); acc += __shfl_xor(acc, 2); acc += __shfl_xor(acc, 4);
            const float y = acc + Dh * xv;
            const float yg = y * silu_f(zv);
            float sq = (q == 0) ? yg * yg : 0.f;
            sq = wave_sum(sq);
            if (q == 0) r[h * 64 + p] = (bf16_t)(pk2(yg, 0.f) & 0xffffu);
            if (lane == 0) atomicAdd(&SSQY[row], (unsigned long long)(sq * SSQ_FIX + 0.5f));
        }
    }
}


struct SsdRegs { uint4 rb[2], rc[2], rx; u32x2 rz; float rdt; };
struct SsdItem { int b, h, ph, g; float Ah, Dh; unsigned offB[2], offC[2], offX, offZ, offDT; };
__device__ __forceinline__ void ssd_load(SsdRegs& R, const bf16_t* BIG, const float* DT, const SsdItem& I, int cc, int wave) {
    const size_t r0 = (size_t)I.b * SEQ_ + (size_t)cc * 64;
    const char* cb = (const char*)BIG + r0 * (BIGW * 2); const char* cd = (const char*)DT + r0 * 128;
#pragma unroll
    for (int i = 0; i < 2; ++i) { R.rb[i] = *(const uint4*)(cb + I.offB[i]); R.rc[i] = *(const uint4*)(cb + I.offC[i]); }
    R.rx = *(const uint4*)(cb + I.offX);
    R.rz = *(const u32x2*)(cb + I.offZ);
    R.rdt = *(const float*)(cd + I.offDT);
}
template <bool DRY>
__device__ __forceinline__ void ssd_chunk(SsdRegs& R, f32x4 (&st)[2], LAS unsigned char* L, bf16_t* BIG, const float* DT, float* SSQY, const SsdItem& I, int c, int tid, int lane, int wave, int li, int pi, int c16, int q4) {
    constexpr int PC = 272, PT = 144;
    constexpr int PB = 288, PX = 96;
    constexpr int CS = 0, BS = 17408, XW = 34816, XI0 = 53248, GG = 65536, SB0 = 74752, SCT = 92160;
    const int XI = XI0 + (c & 1) * 6144, SB = SB0 + (c & 1) * 8704;
    const int trB = (8 * q4 + (c16 >> 2)) * PC + (c16 & 3) * 8, trX = (8 * q4 + (c16 >> 2)) * PX + (c16 & 3) * 8;
#define SSD_TR(base, pitch, troff, ct, kk) __builtin_shufflevector( \
        __builtin_amdgcn_ds_read_tr16_b64_v4i16((LAS s16x4*)(L + (base) + (troff) + (kk) * 32 * (pitch) + (ct) * 32)), \
        __builtin_amdgcn_ds_read_tr16_b64_v4i16((LAS s16x4*)(L + (base) + (troff) + (kk) * 32 * (pitch) + 4 * (pitch) + (ct) * 32)), 0, 1, 2, 3, 4, 5, 6, 7)
#define SSD_FRAG(base, pitch, r0, kk) (*(const LAS bf16x8*)(L + (base) + ((r0) + c16) * (pitch) + (kk) * 64 + q4 * 16))
    const size_t row0 = (size_t)I.b * SEQ_ + (size_t)c * 64;
    const float dtl = R.rdt;
    float acs = dtl * I.Ah;
    acs += dppz<0x111>(acs); acs += dppz<0x112>(acs); acs += dppz<0x114>(acs); acs += dppz<0x118>(acs);
    acs += __builtin_bit_cast(float, __builtin_amdgcn_update_dpp(0, __builtin_bit_cast(int, acs), 0x142, 0xa, 0xf, false));
    acs += __builtin_bit_cast(float, __builtin_amdgcn_update_dpp(0, __builtin_bit_cast(int, acs), 0x143, 0xc, 0xf, false));
    const float tot = __builtin_bit_cast(float, __builtin_amdgcn_readlane(__builtin_bit_cast(int, acs), 63));
    const float wl = dtl * __expf(tot - acs), etot = __expf(tot);
    LAS unsigned char* SCW = L + SCT + wave * 512;
    *(LAS float*)(SCW + lane * 4) = acs; *(LAS float*)(SCW + 256 + lane * 4) = dtl;
#pragma unroll
    for (int pt = 0; pt < 2; ++pt) { u32x2 w; w.x = pk2(st[pt][0], st[pt][1]); w.y = pk2(st[pt][2], st[pt][3]); *(LAS u32x2*)(L + SB + (16 * pt + c16) * PC + (16 * wave + 4 * q4) * 2) = w; }
#pragma unroll
    for (int i = 0; i < 2; ++i) {
        const int id = tid + 512 * i; *(LAS u32x4*)(L + CS + (id >> 4) * PC + (id & 15) * 16) = (u32x4){R.rc[i].x, R.rc[i].y, R.rc[i].z, R.rc[i].w};
        const int n8 = wave + 8 * i; *(LAS u32x4*)(L + BS + lane * PC + n8 * 16) = (u32x4){R.rb[i].x, R.rb[i].y, R.rb[i].z, R.rb[i].w};
    }
    if (wave < 4) *(LAS u32x4*)(L + XI + lane * PX + wave * 16) = (u32x4){R.rx.x, R.rx.y, R.rx.z, R.rx.w};
    else { float f[8]; unpack8(R.rx, f);
        u32x4 xwv; xwv.x = pk2(f[0] * wl, f[1] * wl); xwv.y = pk2(f[2] * wl, f[3] * wl); xwv.z = pk2(f[4] * wl, f[5] * wl); xwv.w = pk2(f[6] * wl, f[7] * wl);
        *(LAS u32x4*)(L + XW + lane * PX + (wave & 3) * 16) = xwv; }
    const u32x2 zc = R.rz;
    __syncthreads();
    if (c + 2 < 64) ssd_load(R, BIG, DT, I, c + 2, wave);
    bf16x8 cfr[4];
    f32x4 stn[2];
    bf16x8 xfr[2][2], bwf[2];
#pragma unroll
    for (int ord = 0; ord < 2; ++ord) {
      if ((ord == 0) == (wave < 4)) {
#pragma unroll
    for (int kk = 0; kk < 4; ++kk) cfr[kk] = SSD_FRAG(CS, PC, 16 * li, kk);
    {
        const int l = 16 * li + c16; const float acs_l = *(const LAS float*)(SCW + l * 4);
#pragma unroll
        for (int t = 0; t < 2; ++t) {
            const int si = 2 * pi + t;
            u32x2 w; w.x = 0u; w.y = 0u;
            if (si <= li) {
                f32x4 d = (f32x4){0.f, 0.f, 0.f, 0.f};
#pragma unroll
                for (int kk = 0; kk < 4; ++kk) d = __builtin_amdgcn_mfma_f32_16x16x32_bf16(SSD_FRAG(BS, PC, 16 * si, kk), cfr[kk], d, 0, 0, 0);
                float gv[4];
                const f32x4 acs_s = *(const LAS f32x4*)(SCW + (16 * si + 4 * q4) * 4), dt_s = *(const LAS f32x4*)(SCW + 256 + (16 * si + 4 * q4) * 4);
#pragma unroll
                for (int e = 0; e < 4; ++e) gv[e] = d[e] * __expf(acs_l - acs_s[e]) * dt_s[e];
                if (si == li) {
#pragma unroll
                    for (int e = 0; e < 4; ++e) gv[e] = (4 * q4 + e <= c16) ? gv[e] : 0.f;
                }
                w.x = pk2(gv[0], gv[1]); w.y = pk2(gv[2], gv[3]);
            }
            *(LAS u32x2*)(L + GG + l * PT + (16 * si + 4 * q4) * 2) = w;
        }
    }

      } else {
#pragma unroll
    for (int kk = 0; kk < 2; ++kk) { bwf[kk] = SSD_TR(BS, PC, trB, wave, kk); xfr[0][kk] = SSD_TR(XW, PX, trX, 0, kk); xfr[1][kk] = SSD_TR(XW, PX, trX, 1, kk); }
#pragma unroll
    for (int pt = 0; pt < 2; ++pt) {
        f32x4 d = st[pt] * etot;
#pragma unroll
        for (int kk = 0; kk < 2; ++kk) d = __builtin_amdgcn_mfma_f32_16x16x32_bf16(bwf[kk], xfr[pt][kk], d, 0, 0, 0);
        stn[pt] = d;
    }

      }
    }
    const bf16x8 xy0 = SSD_TR(XI, PX, trX, pi, 0), xy1 = SSD_TR(XI, PX, trX, pi, 1);
    st[0] = stn[0]; st[1] = stn[1];
    __syncthreads();
    {
        f32x4 d1 = (f32x4){0.f, 0.f, 0.f, 0.f}, d2 = (f32x4){0.f, 0.f, 0.f, 0.f};
#pragma unroll
        for (int kk = 0; kk < 2; ++kk) d1 = __builtin_amdgcn_mfma_f32_16x16x32_bf16(kk ? xy1 : xy0, SSD_FRAG(GG, PT, 16 * li, kk), d1, 0, 0, 0);
#pragma unroll
        for (int kk = 0; kk < 4; ++kk) d2 = __builtin_amdgcn_mfma_f32_16x16x32_bf16(SSD_FRAG(SB, PC, 16 * pi, kk), cfr[kk], d2, 0, 0, 0);
        const int l = 16 * li + c16; const float ea_l = __expf(*(const LAS float*)(SCW + l * 4));
        const float zf[4] = {bf_lo(zc.x), bf_hi(zc.x), bf_lo(zc.y), bf_hi(zc.y)};
        float yg[4], sq = 0.f;
        const u32x2 xr = *(const LAS u32x2*)(L + XI + l * PX + (16 * pi + 4 * q4) * 2);
        const float xs[4] = {bf_lo(xr.x), bf_hi(xr.x), bf_lo(xr.y), bf_hi(xr.y)};
#pragma unroll
        for (int e = 0; e < 4; ++e) { const float xv = xs[e];
            const float y = d1[e] + ea_l * d2[e] + I.Dh * xv; yg[e] = y * silu_f(zf[e]); sq += yg[e] * yg[e]; }
        u32x2 w; w.x = pk2(yg[0], yg[1]); w.y = pk2(yg[2], yg[3]);
        if (!DRY) *(u32x2*)((char*)BIG + row0 * (BIGW * 2) + I.offZ) = w;
        sq += __shfl_xor(sq, 16); sq += __shfl_xor(sq, 32);
        if (DRY) { if (sq == 12345.678f) SSQY[0] = 1.f; } else if (q4 == 0) SSQY[(size_t)(I.h * 4 + I.ph * 2 + pi) * M_ + row0 + l] = sq;
    }
#undef SSD_FRAG
#undef SSD_TR
}
template <bool DRY>
__device__ __forceinline__ void phase_ssd_scan(const Args& a, int j, unsigned char* lds_raw) {
    LAS unsigned char* L = (LAS unsigned char*)lds_raw;
    bf16_t* BIG = (bf16_t*)(a.ws + WS_BIG); const float* DT = (const float*)(a.ws + WS_DT); float* SSQY = (float*)(a.ws + WS_SSQ128);
    const float* A_log = a.in[9] + j * 32; const float* Dp = a.in[10] + j * 32;
    const int tid = opaque_tid(), lane = tid & 63, wave = __builtin_amdgcn_readfirstlane(tid >> 6);
    const int role = (wave == 1) ? 6 : ((wave == 6) ? 1 : wave);
    const int c16 = lane & 15, q4 = lane >> 4, li = role >> 1, pi = role & 1;
    for (int it = blockIdx.x; it < 256; it += gridDim.x) {
        const int xc = it & 7, slot = it >> 3, pair = xc + 8 * (slot >> 3), sub = slot & 7;
        SsdItem I; I.b = pair >> 3; I.g = pair & 7; I.h = I.g * 4 + (sub >> 1); I.ph = sub & 1;
        I.Ah = -__expf(A_log[I.h]); I.Dh = Dp[I.h];
#pragma unroll
        for (int i = 0; i < 2; ++i) { I.offB[i] = (unsigned)(lane * BIGW + 4096 + I.g * 128 + (wave + 8 * i) * 8) * 2u; const int id = tid + 512 * i; I.offC[i] = (unsigned)((id >> 4) * BIGW + 5120 + I.g * 128 + (id & 15) * 8) * 2u; }
        I.offX = (unsigned)(lane * BIGW + DI_ + I.h * 64 + I.ph * 32 + (wave & 3) * 8) * 2u;
        I.offZ = (unsigned)((16 * li + c16) * BIGW + I.h * 64 + I.ph * 32 + 16 * pi + 4 * q4) * 2u;
        I.offDT = (unsigned)(lane * 32 + I.h) * 4u;
        f32x4 st[2]; st[0] = (f32x4){0.f, 0.f, 0.f, 0.f}; st[1] = (f32x4){0.f, 0.f, 0.f, 0.f};
        SsdRegs R0, R1; R0.rx = make_uint4(0, 0, 0, 0); R1.rx = make_uint4(0, 0, 0, 0);
        ssd_load(R0, BIG, DT, I, 0, wave);
        ssd_load(R1, BIG, DT, I, 1, wave);
        for (int c = 0; c < 64; c += 2) {
            ssd_chunk<DRY>(R0, st, L, BIG, DT, SSQY, I, c, tid, lane, wave, li, pi, c16, q4);
            ssd_chunk<DRY>(R1, st, L, BIG, DT, SSQY, I, c + 1, tid, lane, wave, li, pi, c16, q4);
        }
    }
}

constexpr int NPH = 1 + 9 * 4;
__host__ __device__ inline bool phase_exists(int ph) { if (ph == 0) return true; const int li = (ph - 1) / 9, s = (ph - 1) % 9; return !((li & 1) && s == 2) && s != 6; }

__global__ void __launch_bounds__(NTHREADS, 2) mk_fwd(Args a) {
    extern __shared__ __attribute__((aligned(16))) unsigned char lds[];
    unsigned char* ws = a.ws;
    bf16_t* XB = (bf16_t*)(ws + WS_XB); bf16_t* BIG = (bf16_t*)(ws + WS_BIG); float* RSX = (float*)(ws + WS_RSX); float* SSQP = (float*)(ws + WS_SSQP);
    volatile LAS unsigned* bst = (volatile LAS unsigned*)((LAS unsigned char*)lds + 131072);
    if (threadIdx.x == 0) { bst[0] = 0u; bst[1] = 0u; }
    __syncthreads();
    (void)xcd_barrier_post((unsigned*)(ws + WS_BAR), bst);
    const bool fusedres = (FUSE_RESID != 0) && (gridDim.x == 256) && (a.ph_hi - a.ph_lo > 1);
    bool first = true;
    for (int ph = a.ph_lo; ph < a.ph_hi; ++ph) {
        if (!phase_exists(ph)) continue;
        if (fusedres && ph > 0 && ((ph - 1) % 9 == 4 || (ph - 1) % 9 == 8)) continue;
        if (!first) { XcdBarrier xbar; xbar.bar = (unsigned*)(ws + WS_BAR); xbar.x = xb_xcc_id(); xbar.st = bst; xcd_barrier(xbar); if (PROBE == 2) xcd_barrier(xbar); }
        first = false;
        if (ph == 0) { phase_prep(a, (float*)lds); continue; }
        const int li = (ph - 1) / 9, s = (ph - 1) % 9, j = li >> 1; const bool ssd = !(li & 1);
        int kind = -1; const bf16_t* A = nullptr; int lda = 0; const bf16_t* Bt = nullptr; int N = 0, K = 0;
        bf16_t* outp = nullptr; int ldc = 0; const float* ssq_in = nullptr; float inv_k = 0.f;
        if (s == 0 && ssd) { kind = 0; A = XB; lda = 1024; Bt = (const bf16_t*)(ws + WS_SSDIN + j * SZ_SSDIN1); N = BIGW; K = 1024; }
        else if (s == 0) { kind = 1; A = XB; lda = 1024; Bt = (const bf16_t*)(ws + WS_SCIN + j * SZ_SCIN1); N = SCW3; K = 1024; outp = BIG; ldc = 2048; }
        else if (s == 5) { kind = 3; A = XB; lda = 1024; Bt = (const bf16_t*)(ws + WS_FUP + li * SZ_FUP1); N = FH2; K = 1024; }
        else if (s == 3 && ssd) { kind = 2; A = BIG; lda = BIGW; Bt = (const bf16_t*)(ws + WS_SSDOUT + j * SZ_SSDOUT1); N = 1024; K = DI_; outp = BIG + DI_; ldc = BIGW; ssq_in = (const float*)(ws + WS_SSQ128); inv_k = 1.0f / 2048.f; }
        else if (s == 3) { kind = 2; A = BIG; lda = 2048; Bt = (const bf16_t*)(ws + WS_SCOUT + j * SZ_SCOUT1); N = 1024; K = 1024; outp = BIG + 1024; ldc = 2048; }
        else if (s == 7) { kind = 2; A = BIG; lda = FH; Bt = (const bf16_t*)(ws + WS_FDN + li * SZ_FDN1); N = 1024; K = FH; outp = BIG + (size_t)M_ * FH; ldc = 1024; }
        if (kind >= 0) {
          for (int rep = 0; rep < (PROBE == 1 ? 2 : 1); ++rep) {
#if FAST_GEMM
            pg8::Gemm g{A, lda, Bt, M_, N, K}; pg8::StaticOrder S; S.init(M_, N, (int)gridDim.x, (int)blockIdx.x);
            if (s == 7) phase_ffn_fixup(a, li, S);
            if (kind == 0) { EpiSsdIn E{BIG, (float*)(ws + WS_DT), (bf16_t*)(ws + WS_HALO), RSX, a.in[8] + j * 32}; pg8::gemm_phase<EpiSsdIn>((LAS unsigned char*)lds, g, S, E); }
            else if (kind == 1) { EpiPlain E{outp, ldc, RSX}; pg8::gemm_phase<EpiPlain>((LAS unsigned char*)lds, g, S, E); }
            else if (kind == 3) { EpiFfnUp E{BIG, RSX, a.in[17] + (size_t)li * 3 * FH, a.in[18] + (size_t)li * FH, (bf16_t*)(ws + WS_SIDEG), (bf16_t*)(ws + WS_SIDEV)}; pg8::gemm_phase<EpiFfnUp>((LAS unsigned char*)lds, g, S, E); }
            else if (fusedres) { EpiOutFused E{ssq_in, inv_k, XB, (li == 3 && s == 7) ? a.out : nullptr, (s == 3 ? a.in[2] : a.in[4]) + li * 1024, RSX, (float*)(ws + WS_XCH), (unsigned*)(ws + WS_CNT), 16u * (unsigned)(li * 2 + (s == 7 ? 1 : 0) + 1)};
                pg8::gemm_phase<EpiOutFused>((LAS unsigned char*)lds, g, S, E); }
            else { EpiOut E{outp, ldc, ssq_in, inv_k, SSQP}; pg8::gemm_phase<EpiOut>((LAS unsigned char*)lds, g, S, E); }
#if HIDE_CONV
            if (rep == 0) {
                unsigned cmask = 0u;
                if (s == 0 && li == 0) cmask = (1u << 2) | (1u << 8) | (1u << 12);
                else if (s == 5 && li == 0) cmask = (1u << 4) | (1u << 6) | (1u << 9) | (1u << 13);
                else if (s == 5 && li == 1) cmask = (1u << 1) | (1u << 3) | (1u << 10) | (1u << 14);
                else if (s == 0 && li == 2) cmask = (1u << 5) | (1u << 7) | (1u << 11) | (1u << 15);
                if (cmask) {
                    const int G = (int)gridDim.x, rem = S.nwg % G;
                    if (rem == 0) convert_weights(a, (float*)lds, cmask, (int)blockIdx.x, G);
                    else if ((int)blockIdx.x >= rem) convert_weights(a, (float*)lds, cmask, (int)blockIdx.x - rem, G - rem);
                }
            }
#endif
#else
            if (kind == 0) { EpiSsdIn E{BIG, (float*)(ws + WS_DT), (bf16_t*)(ws + WS_HALO), RSX, a.in[8] + j * 32}; gemm_naive<EpiSsdIn>((float*)lds, A, lda, Bt, N, K, E); }
            else if (kind == 1) { EpiPlain E{outp, ldc, RSX}; gemm_naive<EpiPlain>((float*)lds, A, lda, Bt, N, K, E); }
            else { EpiOut E{outp, ldc, ssq_in, inv_k, SSQP}; gemm_naive<EpiOut>((float*)lds, A, lda, Bt, N, K, E); }
#endif
          }
            continue;
        }
        if (s == 1) { if (ssd) phase_ssd_conv_dt(a, j); else phase_sc_conv(a, j); }
        else if (s == 2) {
#if FAST_SSD
            if (PROBE == 3) { phase_ssd_scan<true>(a, j, lds); __syncthreads(); }
            phase_ssd_scan<false>(a, j, lds);
#else
            phase_ssd_scan_naive(a, j);
#endif
        }
        else if (s == 4) { phase_resid(a, a.in[2] + li * 1024, false, ssd ? BIG + DI_ : BIG + 1024, ssd ? BIGW : 2048); }
        else if (s == 8) { phase_resid(a, a.in[4] + li * 1024, li == 3, BIG + (size_t)M_ * FH, 1024); }
    }
}

extern "C" void kernel_launch(void* const* d_in, const int* in_sizes, int n_in, void* d_out, int out_size, void* d_ws, size_t ws_size, hipStream_t stream) {
    static int grid = 0;
    if (grid == 0) {
        if (n_in != 20 || out_size != M_ * D_ || ws_size < WS_END) { fprintf(stderr, "kernel_launch: unexpected shapes (n_in %d out %d ws %zu need %zu)\n", n_in, out_size, ws_size, (size_t)WS_END); grid = -1; return; }
        int dev = 0, cus = 0, per_cu = 0;
        (void)hipGetDevice(&dev); (void)hipDeviceGetAttribute(&cus, hipDeviceAttributeMultiprocessorCount, dev);
        if (hipFuncSetAttribute((const void*)mk_fwd, hipFuncAttributeMaxDynamicSharedMemorySize, LDS_BYTES) != hipSuccess) { fprintf(stderr, "kernel_launch: hipFuncSetAttribute failed\n"); grid = -1; return; }
        if (hipOccupancyMaxActiveBlocksPerMultiprocessor(&per_cu, (const void*)mk_fwd, NTHREADS, LDS_BYTES) != hipSuccess || per_cu < 1) { fprintf(stderr, "kernel_launch: occupancy query failed (%d)\n", per_cu); (void)hipGetLastError(); per_cu = 1; }
        if (per_cu > 1) per_cu = 1;
        grid = cus * per_cu;
        fprintf(stderr, "kernel_launch: grid %d (cus %d), ws %zu need %zu\n", grid, cus, ws_size, (size_t)WS_END);
    }
    if (grid < 0) return;
    Args a{};
    for (int i = 0; i < 20; ++i) a.in[i] = (const float*)d_in[i];
    a.out = (float*)d_out; a.ws = (unsigned char*)d_ws;
    if (hipMemsetAsync((unsigned char*)d_ws + WS_BAR, 0, 32768, stream) != hipSuccess) { fprintf(stderr, "kernel_launch: memset of the barrier words failed\n"); return; }
#if ONE_LAUNCH
    a.ph_lo = 0; a.ph_hi = NPH;
    void* args[] = {&a};
    hipError_t e = hipLaunchCooperativeKernel((const void*)mk_fwd, dim3(grid), dim3(NTHREADS), args, LDS_BYTES, stream);
    if (e != hipSuccess) fprintf(stderr, "cooperative launch failed: %s (grid %d)\n", hipGetErrorString(e), grid);
#else
    for (int ph = 0; ph < NPH; ++ph) {
        if (!phase_exists(ph)) continue;
        a.ph_lo = ph; a.ph_hi = ph + 1;
        hipLaunchKernelGGL(mk_fwd, dim3(grid), dim3(NTHREADS), LDS_BYTES, stream, a);
    }
#endif
}
```

```cpp
#include <hip/hip_runtime.h>
#include <hip/hip_cooperative_groups.h>
#include <cstdio>
#include <cstdint>
namespace cg = cooperative_groups;

#ifndef ONE_LAUNCH
#define ONE_LAUNCH 1
#endif
#ifndef FAST_SSD
#define FAST_SSD 1
#endif
#ifndef PROBE
#define PROBE 0
#endif
#ifndef HIDE_CONV
#define HIDE_CONV 0
#endif
#ifndef FUSE_RESID
#define FUSE_RESID 1
#endif
#ifndef FAST_GEMM
#define FAST_GEMM 1
#endif

#define LAS __attribute__((address_space(3)))
typedef unsigned short bf16_t;
typedef short bf16x8 __attribute__((ext_vector_type(8)));
typedef short s16x4 __attribute__((ext_vector_type(4)));
typedef float f32x4 __attribute__((ext_vector_type(4)));
typedef unsigned u32x4 __attribute__((ext_vector_type(4)));
typedef unsigned u32x2 __attribute__((ext_vector_type(2)));

constexpr int M_ = 16384, D_ = 1024, SEQ_ = 4096;
constexpr int SSD_IN_N = 6176, SSD_IN_PAD = 6400, BIGW = 6144, DI_ = 2048;
constexpr int SCW3 = 3072, FH = 2816, FH2 = 5632;
constexpr float EPS_ = 1e-6f;
constexpr int NTHREADS = 512, NWAVES = 8;
constexpr int LDS_BYTES = 131072 + 16 + 4096;
constexpr int LDS_RSC = 131072 + 16;

constexpr size_t SZ_SSDIN1 = (size_t)SSD_IN_PAD * 1024 * 2;
constexpr size_t SZ_SSDOUT1 = (size_t)1024 * 2048 * 2;
constexpr size_t SZ_SCIN1 = (size_t)3072 * 1024 * 2;
constexpr size_t SZ_SCOUT1 = (size_t)1024 * 1024 * 2;
constexpr size_t SZ_FUP1 = (size_t)FH2 * 1024 * 2;
constexpr size_t SZ_FDN1 = (size_t)1024 * FH * 2;
constexpr size_t WS_SSDIN = 0;
constexpr size_t WS_SSDOUT = WS_SSDIN + 2 * SZ_SSDIN1;
constexpr size_t WS_SCIN = WS_SSDOUT + 2 * SZ_SSDOUT1;
constexpr size_t WS_SCOUT = WS_SCIN + 2 * SZ_SCIN1;
constexpr size_t WS_FUP = WS_SCOUT + 2 * SZ_SCOUT1;
constexpr size_t WS_FDN = WS_FUP + 4 * SZ_FUP1;
constexpr size_t WS_XB = WS_FDN + 4 * SZ_FDN1;
constexpr size_t WS_BIG = WS_XB + (size_t)M_ * 1024 * 2;
constexpr size_t WS_DT = WS_BIG + (size_t)M_ * BIGW * 2;
constexpr size_t WS_HALO = WS_DT + (size_t)M_ * 32 * 4;
constexpr size_t WS_SSQ128 = WS_HALO;
constexpr size_t WS_SIDEG = WS_HALO;
constexpr size_t WS_SIDEV = WS_SIDEG + (size_t)256 * 4 * FH * 2;
constexpr size_t WS_RSX = WS_SIDEV + (size_t)256 * 2 * FH * 2;
constexpr size_t WS_SSQP = WS_RSX + (size_t)M_ * 16;
constexpr size_t WS_SSQY = WS_SSQP + (size_t)M_ * 16 * 4;
constexpr size_t WS_BAR = WS_SSQY + (size_t)2 * M_ * 8;
constexpr size_t WS_CNT = WS_BAR + 16384;
constexpr size_t WS_XCH = WS_CNT + 16384;
constexpr size_t WS_END = WS_XCH + (size_t)64 * 4 * 256 * 4;
constexpr float SSQ_FIX = 16777216.f, SSQ_UNFIX = 1.0f / 16777216.f;
static_assert(WS_END <= 369098752ull, "workspace budget");

#if HIDE_CONV
constexpr unsigned CONV_PREP_MASK = 0x0001u;
#else
constexpr unsigned CONV_PREP_MASK = 0xFFFFu;
#endif
struct Args { const float* in[20]; float* out; unsigned char* ws; int ph_lo, ph_hi; };

__device__ __forceinline__ unsigned pk2(float lo, float hi) { unsigned r; asm volatile("v_cvt_pk_bf16_f32 %0, %1, %2" : "=v"(r) : "v"(lo), "v"(hi)); return r; }
__device__ __forceinline__ float bf_lo(unsigned w) { return __uint_as_float(w << 16); }
__device__ __forceinline__ float bf_hi(unsigned w) { return __uint_as_float(w & 0xffff0000u); }
__device__ __forceinline__ float bf2f(bf16_t h) { return __uint_as_float(((unsigned)h) << 16); }
__device__ __forceinline__ void unpack8(const uint4 v, float* f) {
    f[0] = bf_lo(v.x); f[1] = bf_hi(v.x); f[2] = bf_lo(v.y); f[3] = bf_hi(v.y); f[4] = bf_lo(v.z); f[5] = bf_hi(v.z); f[6] = bf_lo(v.w); f[7] = bf_hi(v.w);
}
__device__ __forceinline__ uint4 pack8(const float* f) { uint4 o; o.x = pk2(f[0], f[1]); o.y = pk2(f[2], f[3]); o.z = pk2(f[4], f[5]); o.w = pk2(f[6], f[7]); return o; }
__device__ __forceinline__ float silu_f(float x) { return x * __builtin_amdgcn_rcpf(1.0f + __expf(-x)); }
__device__ __forceinline__ float softplus_f(float x) { return x > 20.f ? x : log1pf(__expf(x)); }
__device__ __forceinline__ int opaque_tid() { int t = threadIdx.x; asm volatile("" : "+v"(t)); return t; }
__device__ __forceinline__ float rsx(const float* ssqx, int row) { const f32x4 p = *(const f32x4*)(ssqx + (size_t)row * 4); return rsqrtf(((p[0] + p[1]) + (p[2] + p[3])) * (1.0f / 1024.f) + EPS_); }
__device__ __forceinline__ float wave_sum(float v) {
#pragma unroll
    for (int o = 1; o < 64; o <<= 1) v += __shfl_xor(v, o);
    return v;
}


struct RsCache { LAS float* tab; int pm; };
__device__ __forceinline__ void rs_cache_fill(RsCache& C, const float* ssqx, int pm, int wr, int lane) {
    if (C.pm != pm) {
        C.tab[lane] = rsx(ssqx, pm * 256 + wr * 64 + lane); C.tab[64 + lane] = rsx(ssqx, pm * 256 + 128 + wr * 64 + lane);
        C.pm = pm;
    }
}

#define XB_TMO      128
#define XB_XCNT(j)  (256  + 64 * (j))
#define XB_XSUB(j)  (1280 + 64 * (j))
#define XB_XGEN(j)  (2304 + 64 * (j))
#define XB_TOP      3328
#define XB_TOPGEN   3392
#define XCD_BAR_WORDS 3456
#define XB_SPIN_CAP (1u << 20)
__device__ __forceinline__ unsigned xb_ld(unsigned* p)              { return __hip_atomic_load(p, __ATOMIC_RELAXED, __HIP_MEMORY_SCOPE_AGENT); }
__device__ __forceinline__ unsigned xb_add(unsigned* p, unsigned v) { return __hip_atomic_fetch_add(p, v, __ATOMIC_RELAXED, __HIP_MEMORY_SCOPE_AGENT); }
__device__ __forceinline__ unsigned xb_xcc_id() { return (unsigned)__builtin_amdgcn_s_getreg((3 << 11) | 20) & 0xFu; }
#define XB_SPIN(cond, bar) do { unsigned _sp = 0; while (cond) { __builtin_amdgcn_s_sleep(1); \
    if ((++_sp & 255u) == 0u) { if (xb_ld(&(bar)[XB_TMO])) break; if (_sp > XB_SPIN_CAP) { atomicAdd(&(bar)[XB_TMO], 1u); break; } } } } while (0)
struct XcdBarrier { unsigned* bar; unsigned x; volatile LAS unsigned* st; };
__device__ __forceinline__ XcdBarrier xcd_barrier_post(unsigned* bar, volatile LAS unsigned* st) {
    XcdBarrier b; b.bar = bar; b.x = xb_xcc_id(); b.st = st;
    if (threadIdx.x == 0) (void)xb_add(&bar[XB_XCNT(b.x)], 1u);
    return b;
}
__device__ __forceinline__ void xcd_barrier_complete(unsigned* bar, unsigned x, unsigned& nloc, unsigned& nx) {
    const unsigned G = gridDim.x * gridDim.y * gridDim.z;
    unsigned sum, cnt, mine, sp = 0u;
    for (;;) {
        sum = 0u; cnt = 0u; mine = 0u;
#pragma unroll
        for (unsigned jx = 0; jx < 16; ++jx) { const unsigned c = xb_ld(&bar[XB_XCNT(jx)]); sum += c; cnt += (c > 0u) ? 1u : 0u; mine = (jx == x) ? c : mine; }
        if (sum == G) break;
        __builtin_amdgcn_s_sleep(1);
        if ((++sp & 255u) == 0u) { if (xb_ld(&bar[XB_TMO])) break; if (sp > XB_SPIN_CAP) { atomicAdd(&bar[XB_TMO], 1u); break; } }
    }
    nloc = mine > 0u ? mine : 1u; nx = cnt > 0u ? cnt : 1u;
}
__device__ __forceinline__ void xcd_barrier(const XcdBarrier& b) {
    asm volatile("s_waitcnt vmcnt(0)" ::: "memory");
    __syncthreads();
    if (threadIdx.x == 0) {
        unsigned* bar = b.bar;
        __builtin_amdgcn_s_waitcnt(0);
        unsigned nloc = b.st[0], nx = b.st[1];
        if (nloc == 0u) { xcd_barrier_complete(bar, b.x, nloc, nx); b.st[0] = nloc; b.st[1] = nx; }
        const unsigned old = xb_add(&bar[XB_XSUB(b.x)], 1u);
        const unsigned gen = old / nloc;
        if (old + 1u == (gen + 1u) * nloc) {
            __builtin_amdgcn_fence(__ATOMIC_RELEASE, "agent");
            asm volatile("s_waitcnt vmcnt(0)" ::: "memory");
            const unsigned og = xb_add(&bar[XB_TOP], 1u);
            const unsigned tg = og / nx;
            if (og + 1u == (tg + 1u) * nx) xb_add(&bar[XB_TOPGEN], 1u);
            else XB_SPIN(xb_ld(&bar[XB_TOPGEN]) == tg, bar);
            __builtin_amdgcn_fence(__ATOMIC_ACQUIRE, "agent");
            xb_add(&bar[XB_XGEN(b.x)], 1u);
            asm volatile("s_waitcnt vmcnt(0)" ::: "memory");
        } else {
            XB_SPIN(xb_ld(&bar[XB_XGEN(b.x)]) == gen, bar);
            __builtin_amdgcn_fence(__ATOMIC_ACQUIRE, "agent");
            asm volatile("s_waitcnt vmcnt(0)" ::: "memory");
        }
    }
    __syncthreads();
}

namespace pg8 {
constexpr int BM = 256, BK = 64, HALF = 128, HTB = HALF * BK * 2, STAGE_BYTES = 8 * HTB, NXCD = 8, WGM = 8;
__host__ __device__ __forceinline__ int lds_byte(int r, int c) { const int st = (r >> 4) * 2 + (c >> 5), rr = r & 15, cc = c & 31, ob = rr * 64 + cc * 2; return st * 1024 + (ob ^ (((ob >> 9) & 1) << 5)); }
__host__ __device__ __forceinline__ void stage_rc(int b, int& R, int& C) { const int st = b / 1024, sb = b % 1024, swz = sb ^ (((sb >> 9) & 1) << 5); R = (st >> 1) * 16 + swz / 64; C = (st & 1) * 32 + (swz % 64) / 2; }
__host__ __device__ __forceinline__ int perm32(int rho) { const int n = rho >> 4, i = rho & 15; return 8 * (i >> 2) + 4 * n + (i & 3); }
struct Unit { int pm, pn; };
struct Gemm { const bf16_t* A; int lda; const bf16_t* Bt; int M, N, K; };
struct StaticOrder {
    int nM, nN, nwg, G, c;
    __host__ __device__ void init(int M, int N, int G_, int c_) { nM = M / BM; nN = N / BM; nwg = nM * nN; G = G_; c = c_; }
    __host__ __device__ bool next(int i, Unit& u) const {
        const long L = (long)i * G + c; if (L >= nwg) return false;
        int wgid = (int)L; { const int q = nwg / NXCD, r = nwg % NXCD, xcd = wgid % NXCD, off = wgid / NXCD; wgid = (xcd < r ? xcd * (q + 1) : r * (q + 1) + (xcd - r) * q) + off; }
        const int nig = WGM * nN, gid = wgid / nig, fm = gid * WGM, gsz = (nM - fm) < WGM ? (nM - fm) : WGM;
        u.pm = fm + ((wgid % nig) % gsz); u.pn = (wgid % nig) / gsz; return true;
    }
};

template <class Epi, bool ALIGN_EPI = true>
__device__ __forceinline__ void gemm_phase(LAS unsigned char* lds, const Gemm g, const StaticOrder& S, const Epi& E) {
    const int tid = opaque_tid(), wid = __builtin_amdgcn_readfirstlane(tid >> 6), lane = tid & 63, wr = wid >> 2, wc = wid & 3, fr = lane & 15, fq = lane >> 4;
    const int K = g.K, nt = K / BK, lda = g.lda;
    unsigned voffA[2], voffB[2];
#pragma unroll
    for (int i = 0; i < 2; ++i) { int R, C; stage_rc(tid * 16 + i * 8192, R, C); const int Rb = (R & ~31) + perm32(R & 31); voffA[i] = (unsigned)(R * lda + C) * 2u; voffB[i] = (unsigned)(Rb * K + C) * 2u; }
    const size_t kstep = (size_t)(BK * 2);
    const size_t hsA = (size_t)HALF * lda * 2, hsB = (size_t)HALF * K * 2;
    const size_t tsA = 2 * hsA, tsB = 2 * hsB;
    const unsigned ldsw = (unsigned)wid * 1024u;
    const int aoff = lds_byte(wr * 64 + fr, fq * 8), boff = lds_byte(wc * 32 + fr, fq * 8);
#define PG8_SA(b, h) (((b) * 2 + (h)) * HTB)
#define PG8_SB(b, h) ((4 + (b) * 2 + (h)) * HTB)
#define PG8_STAGE(bufoff, gbase, voff) do { _Pragma("unroll") for (int _i = 0; _i < 2; ++_i) \
        __builtin_amdgcn_global_load_lds((const unsigned*)((const char*)(gbase) + (voff)[_i]), (LAS unsigned*)(lds + (bufoff) + ldsw + _i * 8192), 16, 0, 0); } while (0)
#define PG8_LDA(dst, b, h) do { _Pragma("unroll") for (int m = 0; m < 4; ++m) _Pragma("unroll") for (int k = 0; k < 2; ++k) dst[m][k] = *(const LAS bf16x8*)(lds + PG8_SA(b, h) + aoff + m * 2048 + k * 1024); } while (0)
#define PG8_LDB(dst, b, h) do { _Pragma("unroll") for (int n = 0; n < 2; ++n) _Pragma("unroll") for (int k = 0; k < 2; ++k) dst[n][k] = *(const LAS bf16x8*)(lds + PG8_SB(b, h) + boff + n * 2048 + k * 1024); } while (0)
#define PG8_MMA(ai, bj, At, Bt) do { __builtin_amdgcn_s_setprio(1); _Pragma("unroll") for (int m = 0; m < 4; ++m) _Pragma("unroll") for (int n = 0; n < 2; ++n) _Pragma("unroll") for (int k = 0; k < 2; ++k) \
        acc[ai][bj][m][n] = __builtin_amdgcn_mfma_f32_16x16x32_bf16(Bt[n][k], At[m][k], acc[ai][bj][m][n], 0, 0, 0); __builtin_amdgcn_s_setprio(0); } while (0)
#define PG8_WAIT_V(n) asm volatile("s_waitcnt vmcnt(" #n ")" ::: "memory")
#define PG8_WAIT_L(n) asm volatile("s_waitcnt lgkmcnt(" #n ")" ::: "memory")
#define PG8_BAR __builtin_amdgcn_s_barrier()
#define PG8_SCHED __builtin_amdgcn_sched_barrier(0)
    Unit cur, nxt; int ui = 0;
    if (!S.next(0, cur)) return;
    RsCache rsc; rsc.tab = (LAS float*)(lds + LDS_RSC + wid * 512); rsc.pm = -1;
    f32x4 acc[2][2][4][2];
#pragma unroll
    for (int a = 0; a < 2; ++a)
#pragma unroll
        for (int b = 0; b < 2; ++b)
#pragma unroll
            for (int m = 0; m < 4; ++m)
#pragma unroll
                for (int n = 0; n < 2; ++n) acc[a][b][m][n] = (f32x4){0.f, 0.f, 0.f, 0.f};
    bf16x8 At[4][2], B0[2][2], B1[2][2];
    const char* cA = (const char*)g.A + (size_t)cur.pm * tsA; const char* cB = (const char*)g.Bt + (size_t)cur.pn * tsB;
    PG8_STAGE(PG8_SB(0, 0), cB, voffB); PG8_STAGE(PG8_SB(0, 1), cB + hsB, voffB); PG8_STAGE(PG8_SA(0, 0), cA, voffA); PG8_STAGE(PG8_SA(0, 1), cA + hsA, voffA);
    if (wr == 1) PG8_BAR;
    PG8_WAIT_V(2); PG8_BAR;
    PG8_STAGE(PG8_SB(1, 0), cB + kstep, voffB); PG8_STAGE(PG8_SA(1, 0), cA + kstep, voffA); PG8_STAGE(PG8_SB(1, 1), cB + hsB + kstep, voffB);
    PG8_WAIT_V(6); PG8_BAR;
    for (;;) {
        const bool has_next = S.next(ui + 1, nxt);
        const char* nA = has_next ? (const char*)g.A + (size_t)nxt.pm * tsA : cA; const char* nB = has_next ? (const char*)g.Bt + (size_t)nxt.pn * tsB : cB;
        for (int t = 0; t < nt; t += 2) {
            const bool last = (t == nt - 2);
            const char* a1 = cA + (size_t)(t + 1) * kstep;
            const char* a2 = last ? nA : cA + (size_t)(t + 2) * kstep; const char* b2 = last ? nB : cB + (size_t)(t + 2) * kstep;
            const char* a3 = a2 + kstep; const char* b3 = b2 + kstep;
            PG8_LDB(B0, 0, 0); PG8_LDB(B1, 0, 1); PG8_SCHED; PG8_LDA(At, 0, 0); PG8_STAGE(PG8_SA(1, 1), a1 + hsA, voffA);
            PG8_WAIT_V(8); PG8_WAIT_L(0); PG8_BAR; PG8_MMA(0, 0, At, B0); PG8_MMA(0, 1, At, B1); PG8_BAR; PG8_SCHED;
            PG8_LDA(At, 0, 1); PG8_STAGE(PG8_SB(0, 0), b2, voffB); PG8_STAGE(PG8_SB(0, 1), b2 + hsB, voffB); PG8_STAGE(PG8_SA(0, 0), a2, voffA);
            PG8_WAIT_V(8); PG8_WAIT_L(0); PG8_BAR; PG8_MMA(1, 0, At, B0); PG8_MMA(1, 1, At, B1); PG8_BAR; PG8_SCHED;
            PG8_LDB(B0, 1, 0); PG8_LDB(B1, 1, 1); PG8_SCHED; PG8_LDA(At, 1, 0); PG8_STAGE(PG8_SA(0, 1), a2 + hsA, voffA);
            PG8_WAIT_V(8); PG8_WAIT_L(0); PG8_BAR; PG8_MMA(0, 0, At, B0); PG8_MMA(0, 1, At, B1); PG8_BAR; PG8_SCHED;
            PG8_LDA(At, 1, 1); PG8_STAGE(PG8_SB(1, 0), b3, voffB); PG8_STAGE(PG8_SB(1, 1), b3 + hsB, voffB); PG8_STAGE(PG8_SA(1, 0), a3, voffA);
            PG8_WAIT_V(8); PG8_WAIT_L(0); PG8_BAR; PG8_MMA(1, 0, At, B0); PG8_MMA(1, 1, At, B1); PG8_BAR; PG8_SCHED;
        }
        if constexpr (ALIGN_EPI) { if (wr == 0) PG8_BAR; }
        if constexpr (!Epi::AFTER_DRAIN) E.fast(acc, cur, wr, wc, fr, fq, rsc);
        if (!has_next) break;
#pragma unroll
        for (int a = 0; a < 2; ++a)
#pragma unroll
            for (int b = 0; b < 2; ++b)
#pragma unroll
                for (int m = 0; m < 4; ++m)
#pragma unroll
                    for (int n = 0; n < 2; ++n) acc[a][b][m][n] = (f32x4){0.f, 0.f, 0.f, 0.f};
        cur = nxt; cA = nA; cB = nB; ++ui;
        if constexpr (ALIGN_EPI) { if (wr == 1) PG8_BAR; }
    }
    PG8_WAIT_V(0);
    if constexpr (!ALIGN_EPI) { if (wr == 0) PG8_BAR; }
    PG8_BAR;
    if constexpr (Epi::AFTER_DRAIN) E.fused(acc, cur, wr, wc, fr, fq, lds, wid, lane);
#undef PG8_SA
#undef PG8_SB
#undef PG8_STAGE
#undef PG8_LDA
#undef PG8_LDB
#undef PG8_MMA
#undef PG8_WAIT_V
#undef PG8_WAIT_L
#undef PG8_BAR
#undef PG8_SCHED
}
}

template <class Epi>
__device__ __forceinline__ void gemm_naive(float* ldsf, const bf16_t* A, int lda, const bf16_t* Bt, int N, int K, const Epi& E) {
    float* As = ldsf;
    float* Bs = ldsf + 32 * 132;
    const int tid = opaque_tid(), tx = tid & 15, ty = tid >> 4;
    const int ntn = N / 64, ntiles = (M_ / 128) * ntn;
    for (int tile = blockIdx.x; tile < ntiles; tile += gridDim.x) {
        const int tm = tile / ntn, tn = tile % ntn, row0 = tm * 128, col0 = tn * 64;
        float acc[4][4];
#pragma unroll
        for (int i = 0; i < 4; ++i)
#pragma unroll
            for (int jj = 0; jj < 4; ++jj) acc[i][jj] = 0.f;
        for (int k0 = 0; k0 < K; k0 += 32) {
            __syncthreads();
            { const int r = tid >> 2, kc = (tid & 3) * 8; const uint4 v = *(const uint4*)(A + (size_t)(row0 + r) * lda + k0 + kc); float f[8]; unpack8(v, f);
#pragma unroll
              for (int i = 0; i < 8; ++i) As[(kc + i) * 132 + r] = f[i]; }
            if (tid < 256) { const int n = tid >> 2, kc = (tid & 3) * 8; const uint4 v = *(const uint4*)(Bt + (size_t)(col0 + n) * K + k0 + kc); float f[8]; unpack8(v, f);
#pragma unroll
              for (int i = 0; i < 8; ++i) Bs[(kc + i) * 68 + n] = f[i]; }
            __syncthreads();
#pragma unroll 8
            for (int k = 0; k < 32; ++k) {
                const float4 a4 = *(const float4*)&As[k * 132 + ty * 4]; const float4 b4 = *(const float4*)&Bs[k * 68 + tx * 4];
                const float av[4] = {a4.x, a4.y, a4.z, a4.w}, bv[4] = {b4.x, b4.y, b4.z, b4.w};
#pragma unroll
                for (int i = 0; i < 4; ++i)
#pragma unroll
                    for (int jj = 0; jj < 4; ++jj) acc[i][jj] += av[i] * bv[jj];
            }
        }
#pragma unroll
        for (int i = 0; i < 4; ++i) {
            const int row = row0 + ty * 4 + i; const float rs = E.row_scale(row);
            float s = E.apply4(row, col0 + tx * 4, (f32x4){acc[i][0], acc[i][1], acc[i][2], acc[i][3]}, rs);
            if (Epi::SSQ) { s += __shfl_xor(s, 1); s += __shfl_xor(s, 2); s += __shfl_xor(s, 4); s += __shfl_xor(s, 8); if (tx == 0) E.put_ssq(row, tn, s); }
        }
    }
    __syncthreads();
}


struct EpiSsdIn {
    static constexpr bool AFTER_DRAIN = false;
    static constexpr bool SSQ = false;
    bf16_t* big; float* dt; bf16_t* halo; const float* rs; const float* dt_bias;
    __device__ __forceinline__ float row_scale(int row) const { return rsx(rs, row); }
    __device__ __forceinline__ float apply4(int row, int col, f32x4 v, float s) const {
        v = v * s;
        if (col < BIGW) {
            u32x2 w; w.x = pk2(v[0], v[1]); w.y = pk2(v[2], v[3]);
            *(u32x2*)(big + (size_t)row * BIGW + col) = w;
            if (col >= DI_ && (row & 63) >= 61) *(u32x2*)(halo + ((size_t)(row >> 6) * 3 + ((row & 63) - 61)) * 4096 + (col - DI_)) = w;
        } else if (col < SSD_IN_N) {
            const f32x4 b = *(const f32x4*)(dt_bias + (col - BIGW));
            f32x4 o; o[0] = softplus_f(v[0] + b[0]); o[1] = softplus_f(v[1] + b[1]); o[2] = softplus_f(v[2] + b[2]); o[3] = softplus_f(v[3] + b[3]);
            *(f32x4*)(dt + (size_t)row * 32 + (col - BIGW)) = o;
        }
        return 0.f;
    }
    __device__ __forceinline__ void put_ssq(int, int, float) const {}
    __device__ __forceinline__ void fast(const f32x4 (&acc)[2][2][4][2], const pg8::Unit& u, int wr, int wc, int fr, int fq, RsCache& rsc) const {
        asm volatile("" : "+v"(fr), "+v"(fq));
        rs_cache_fill(rsc, rs, u.pm, wr, fq * 16 + fr);
        const int row0 = u.pm * 256 + wr * 64 + fr;
        if (u.pn < 24) {
            const int cb = u.pn * 256 + wc * 32 + 8 * fq; const bool hal = (u.pn >= 8) && (fr >= 13);
#pragma unroll
            for (int ai = 0; ai < 2; ++ai)
#pragma unroll
                for (int m = 0; m < 4; ++m) { const int row = row0 + ai * 128 + m * 16; const float s = rsc.tab[ai * 64 + m * 16 + fr]; bf16_t* rowp = big + (size_t)row * BIGW + cb;
#pragma unroll
                    for (int bj = 0; bj < 2; ++bj) { const f32x4 v0 = acc[ai][bj][m][0] * s, v1 = acc[ai][bj][m][1] * s;
                        u32x4 w; w.x = pk2(v0[0], v0[1]); w.y = pk2(v0[2], v0[3]); w.z = pk2(v1[0], v1[1]); w.w = pk2(v1[2], v1[3]);
                        *(u32x4*)(rowp + bj * 128) = w;
                        if (m == 3 && hal) *(u32x4*)(halo + ((size_t)(row >> 6) * 3 + (fr - 13)) * 4096 + (cb - DI_) + bj * 128) = w; }
                    asm volatile("" ::: "memory"); }
        } else if (wc == 0) {
            const f32x4 b0 = *(const f32x4*)(dt_bias + 8 * fq), b1 = *(const f32x4*)(dt_bias + 8 * fq + 4);
#pragma unroll
            for (int ai = 0; ai < 2; ++ai)
#pragma unroll
                for (int m = 0; m < 4; ++m) { const int row = row0 + ai * 128 + m * 16; const float s = rsc.tab[ai * 64 + m * 16 + fr];
                    const f32x4 v0 = acc[ai][0][m][0] * s + b0, v1 = acc[ai][0][m][1] * s + b1; f32x4 o0, o1;
#pragma unroll
                    for (int e = 0; e < 4; ++e) { o0[e] = softplus_f(v0[e]); o1[e] = softplus_f(v1[e]); }
                    float* dp = dt + (size_t)row * 32 + 8 * fq; *(f32x4*)dp = o0; *(f32x4*)(dp + 4) = o1;
                    asm volatile("" ::: "memory"); }
        }
    }
};
struct EpiPlain {
    static constexpr bool AFTER_DRAIN = false;
    static constexpr bool SSQ = false;
    bf16_t* out; int ldc; const float* rs;
    __device__ __forceinline__ float row_scale(int row) const { return rsx(rs, row); }
    __device__ __forceinline__ float apply4(int row, int col, f32x4 v, float s) const {
        v = v * s; u32x2 w; w.x = pk2(v[0], v[1]); w.y = pk2(v[2], v[3]);
        *(u32x2*)(out + (size_t)row * ldc + col) = w; return 0.f;
    }
    __device__ __forceinline__ void put_ssq(int, int, float) const {}
    __device__ __forceinline__ void fast(const f32x4 (&acc)[2][2][4][2], const pg8::Unit& u, int wr, int wc, int fr, int fq, RsCache& rsc) const {
        asm volatile("" : "+v"(fr), "+v"(fq));
        rs_cache_fill(rsc, rs, u.pm, wr, fq * 16 + fr);
        const int row0 = u.pm * 256 + wr * 64 + fr;
        if (u.pn < 8) {
            const int cb = 1024 + u.pn * 128 + wc * 32 + 8 * fq;
#pragma unroll
            for (int ai = 0; ai < 2; ++ai)
#pragma unroll
                for (int m = 0; m < 4; ++m) { const int row = row0 + ai * 128 + m * 16; const float s = rsc.tab[ai * 64 + m * 16 + fr]; const float s2 = s * s;
                    const f32x4 v0 = acc[ai][0][m][0] * acc[ai][1][m][0] * s2, v1 = acc[ai][0][m][1] * acc[ai][1][m][1] * s2;
                    u32x4 w; w.x = pk2(v0[0], v0[1]); w.y = pk2(v0[2], v0[3]); w.z = pk2(v1[0], v1[1]); w.w = pk2(v1[2], v1[3]);
                    *(u32x4*)(out + (size_t)row * ldc + cb) = w;
                    asm volatile("" ::: "memory"); }
        } else {
            const int cb = (u.pn - 8) * 256 + wc * 32 + 8 * fq;
#pragma unroll
            for (int ai = 0; ai < 2; ++ai)
#pragma unroll
                for (int m = 0; m < 4; ++m) { const int row = row0 + ai * 128 + m * 16; const float s = rsc.tab[ai * 64 + m * 16 + fr]; bf16_t* rowp = out + (size_t)row * ldc + cb;
#pragma unroll
                    for (int bj = 0; bj < 2; ++bj) { const f32x4 v0 = acc[ai][bj][m][0] * s, v1 = acc[ai][bj][m][1] * s;
                        u32x4 w; w.x = pk2(v0[0], v0[1]); w.y = pk2(v0[2], v0[3]); w.z = pk2(v1[0], v1[1]); w.w = pk2(v1[2], v1[3]);
                        *(u32x4*)(rowp + bj * 128) = w; }
                    asm volatile("" ::: "memory"); }
        }
    }
};
struct EpiOut {
    static constexpr bool AFTER_DRAIN = false;
    static constexpr bool SSQ = true;
    bf16_t* F; int ldf; const float* ssq_in; float inv_k; float* ssqp;
    __device__ __forceinline__ float row_scale(int row) const { if (!ssq_in) return 1.0f; float t = 0.f; for (int k = 0; k < 128; ++k) t += ssq_in[(size_t)k * M_ + row]; return rsqrtf(t * inv_k + EPS_); }
    __device__ __forceinline__ float apply4(int row, int col, f32x4 v, float s) const {
        v = v * s; u32x2 w; w.x = pk2(v[0], v[1]); w.y = pk2(v[2], v[3]);
        *(u32x2*)(F + (size_t)row * ldf + col) = w;
        return (v[0] * v[0] + v[1] * v[1]) + (v[2] * v[2] + v[3] * v[3]);
    }
    __device__ __forceinline__ void put_ssq(int row, int slot, float s) const { ssqp[(size_t)row * 16 + slot] = s; }
    __device__ __forceinline__ void fast(const f32x4 (&acc)[2][2][4][2], const pg8::Unit& u, int wr, int wc, int fr, int fq, RsCache& rsc) const {
        asm volatile("" : "+v"(fr), "+v"(fq));
        const int row0 = u.pm * 256 + wr * 64 + fr, cb = u.pn * 256 + wc * 32 + 8 * fq;
#pragma unroll
        for (int ai = 0; ai < 2; ++ai)
#pragma unroll
            for (int m = 0; m < 4; ++m) { const int row = row0 + ai * 128 + m * 16; const float s = row_scale(row); bf16_t* rowp = F + (size_t)row * ldf + cb; float q = 0.f;
#pragma unroll
                for (int bj = 0; bj < 2; ++bj) { const f32x4 v0 = acc[ai][bj][m][0] * s, v1 = acc[ai][bj][m][1] * s;
                    u32x4 w; w.x = pk2(v0[0], v0[1]); w.y = pk2(v0[2], v0[3]); w.z = pk2(v1[0], v1[1]); w.w = pk2(v1[2], v1[3]);
                    *(u32x4*)(rowp + bj * 128) = w;
                    q += ((v0[0] * v0[0] + v0[1] * v0[1]) + (v0[2] * v0[2] + v0[3] * v0[3])) + ((v1[0] * v1[0] + v1[1] * v1[1]) + (v1[2] * v1[2] + v1[3] * v1[3])); }
                q += __shfl_xor(q, 16); q += __shfl_xor(q, 32);
                if (fq == 0) ssqp[(size_t)row * 16 + u.pn * 4 + wc] = q;
                asm volatile("" ::: "memory"); }
    }
};


struct EpiOutFused {
    static constexpr bool AFTER_DRAIN = true;
    const float* ssq_in; float inv_k;
    bf16_t* XB; float* outf; const float* gain; float* ssqx; float* xch; unsigned* cnt; unsigned target;
    __device__ __forceinline__ void fast(const f32x4 (&)[2][2][4][2], const pg8::Unit&, int, int, int, int, RsCache&) const {}
    __device__ __forceinline__ void fused(f32x4 (&acc)[2][2][4][2], const pg8::Unit& u, int wr, int wc, int fr, int fq, LAS unsigned char* lds, int wid, int lane) const {
        LAS float* P = (LAS float*)lds;
        LAS float* S = (LAS float*)(lds + 4096);
        const int tid = wid * 64 + lane;
        LAS float* S0 = (LAS float*)(lds + 8192);
        if (ssq_in) {
            const int r = tid & 255, hf = tid >> 8; const float* p = ssq_in + (size_t)(hf * 64) * M_ + (size_t)u.pm * 256 + r; float t = 0.f;
#pragma unroll 16
            for (int k = 0; k < 64; ++k) t += p[(size_t)k * M_];
            S0[hf * 256 + r] = t;
            asm volatile("s_waitcnt lgkmcnt(0)" ::: "memory"); __builtin_amdgcn_s_barrier(); asm volatile("" ::: "memory");
        }
#pragma unroll
        for (int ai = 0; ai < 2; ++ai)
#pragma unroll
            for (int m = 0; m < 4; ++m) {
                const int rl = ai * 128 + wr * 64 + m * 16 + fr; const int row = u.pm * 256 + rl;
                const float s = ssq_in ? rsqrtf((S0[rl] + S0[256 + rl]) * inv_k + EPS_) : 1.0f; (void)row;
                float q = 0.f;
#pragma unroll
                for (int bj = 0; bj < 2; ++bj)
#pragma unroll
                    for (int n = 0; n < 2; ++n) { f32x4 v = acc[ai][bj][m][n] * s; acc[ai][bj][m][n] = v; q += (v[0] * v[0] + v[1] * v[1]) + (v[2] * v[2] + v[3] * v[3]); }
                q += __shfl_xor(q, 16); q += __shfl_xor(q, 32);
                if (fq == 0) P[rl * 4 + wc] = q;
            }
        asm volatile("s_waitcnt lgkmcnt(0)" ::: "memory"); __builtin_amdgcn_s_barrier(); asm volatile("" ::: "memory");
        if (tid < 256) {
            const f32x4 p = *(const LAS f32x4*)(P + tid * 4);
            __hip_atomic_store(xch + ((size_t)u.pm * 4 + u.pn) * 256 + tid, (p[0] + p[1]) + (p[2] + p[3]), __ATOMIC_RELAXED, __HIP_MEMORY_SCOPE_AGENT);
        }
        asm volatile("s_waitcnt vmcnt(0)" ::: "memory");
        if (wid < 4 && lane == 0) __hip_atomic_fetch_add(cnt + 64 * u.pm, 1u, __ATOMIC_RELAXED, __HIP_MEMORY_SCOPE_AGENT);
        const int cb = u.pn * 256 + wc * 32 + 8 * fq;
        uint4 xold[4][2];
#pragma unroll
        for (int m = 0; m < 4; ++m)
#pragma unroll
            for (int bj = 0; bj < 2; ++bj) xold[m][bj] = *(const uint4*)(XB + (size_t)(u.pm * 256 + wr * 64 + m * 16 + fr) * 1024 + cb + bj * 128);
        if (wid == 0) {
            unsigned sp = 0;
            while ((unsigned)__builtin_amdgcn_readfirstlane(__hip_atomic_load(cnt + 64 * u.pm, __ATOMIC_RELAXED, __HIP_MEMORY_SCOPE_AGENT)) < target) { __builtin_amdgcn_s_sleep(1); if (++sp > (1u << 22)) break; }
        }
        asm volatile("s_waitcnt lgkmcnt(0)" ::: "memory"); __builtin_amdgcn_s_barrier(); asm volatile("" ::: "memory");
        if (tid < 256) {
            float t = 0.f;
#pragma unroll
            for (int k = 0; k < 4; ++k) t += __hip_atomic_load(xch + ((size_t)u.pm * 4 + k) * 256 + tid, __ATOMIC_RELAXED, __HIP_MEMORY_SCOPE_AGENT);
            S[tid] = rsqrtf(t * (1.0f / 1024.f) + EPS_);
        }
        asm volatile("s_waitcnt vmcnt(0) lgkmcnt(0)" ::: "memory"); __builtin_amdgcn_s_barrier(); asm volatile("" ::: "memory");
        f32x4 g4[2][2];
#pragma unroll
        for (int bj = 0; bj < 2; ++bj) { g4[bj][0] = *(const f32x4*)(gain + cb + bj * 128); g4[bj][1] = *(const f32x4*)(gain + cb + bj * 128 + 4); }
#pragma unroll
        for (int ai = 0; ai < 2; ++ai) {
            if (ai == 1) {
#pragma unroll
                for (int m = 0; m < 4; ++m)
#pragma unroll
                    for (int bj = 0; bj < 2; ++bj) xold[m][bj] = *(const uint4*)(XB + (size_t)(u.pm * 256 + 128 + wr * 64 + m * 16 + fr) * 1024 + cb + bj * 128);
            }
#pragma unroll
            for (int m = 0; m < 4; ++m) {
                const int rl = ai * 128 + wr * 64 + m * 16 + fr; const size_t off = (size_t)(u.pm * 256 + rl) * 1024 + cb;
                const float rsf = S[rl]; float q = 0.f;
#pragma unroll
                for (int bj = 0; bj < 2; ++bj) {
                    float xo[8]; unpack8(xold[m][bj], xo);
                    f32x4 v0 = acc[ai][bj][m][0] * rsf * g4[bj][0], v1 = acc[ai][bj][m][1] * rsf * g4[bj][1];
                    float xn[8];
#pragma unroll
                    for (int e = 0; e < 4; ++e) { xn[e] = xo[e] + v0[e]; xn[4 + e] = xo[4 + e] + v1[e]; }
                    if (outf) { *(f32x4*)(outf + off + bj * 128) = (f32x4){xn[0], xn[1], xn[2], xn[3]}; *(f32x4*)(outf + off + bj * 128 + 4) = (f32x4){xn[4], xn[5], xn[6], xn[7]}; }
                    else { *(uint4*)(XB + off + bj * 128) = pack8(xn); }
#pragma unroll
                    for (int e = 0; e < 8; ++e) q += xn[e] * xn[e];
                }
                q += __shfl_xor(q, 16); q += __shfl_xor(q, 32);
                if (fq == 0) P[rl * 4 + wc] = q;
            }
            asm volatile("" ::: "memory");
        }
        asm volatile("s_waitcnt lgkmcnt(0)" ::: "memory"); __builtin_amdgcn_s_barrier(); asm volatile("" ::: "memory");
        if (tid < 256 && !outf) { const f32x4 p = *(const LAS f32x4*)(P + tid * 4); ssqx[(size_t)(u.pm * 256 + tid) * 4 + u.pn] = (p[0] + p[1]) + (p[2] + p[3]); }
    }
};

template <int CTRL> __device__ __forceinline__ float dppz(float x) { return __builtin_bit_cast(float, __builtin_amdgcn_update_dpp(0, __builtin_bit_cast(int, x), CTRL, 0xf, 0xf, true)); }
struct EpiFfnUp {
    static constexpr bool AFTER_DRAIN = false;
    bf16_t* act; const float* rs; const float* cw; const float* cb; bf16_t* sideg; bf16_t* sidev;
    __device__ __forceinline__ void fast(const f32x4 (&acc)[2][2][4][2], const pg8::Unit& u, int wr, int wc, int fr, int fq, RsCache& rsc) const {
        asm volatile("" : "+v"(fr), "+v"(fq));
        rs_cache_fill(rsc, rs, u.pm, wr, fq * 16 + fr);
        typedef float f32x2 __attribute__((ext_vector_type(2)));
        const int ch = u.pn * 128 + wc * 32 + 8 * fq;
        f32x2 w0[4], w1[4], w2[4], bb[4];
#pragma unroll
        for (int h = 0; h < 2; ++h) { const f32x4 t0 = *(const f32x4*)(cw + ch + 4 * h), t1 = *(const f32x4*)(cw + FH + ch + 4 * h), t2 = *(const f32x4*)(cw + 2 * FH + ch + 4 * h), t3 = *(const f32x4*)(cb + ch + 4 * h);
            w0[2 * h] = (f32x2){t0[0], t0[1]}; w0[2 * h + 1] = (f32x2){t0[2], t0[3]}; w1[2 * h] = (f32x2){t1[0], t1[1]}; w1[2 * h + 1] = (f32x2){t1[2], t1[3]};
            w2[2 * h] = (f32x2){t2[0], t2[1]}; w2[2 * h + 1] = (f32x2){t2[2], t2[3]}; bb[2 * h] = (f32x2){t3[0], t3[1]}; bb[2 * h + 1] = (f32x2){t3[2], t3[3]}; }
#pragma unroll
        for (int ai = 0; ai < 2; ++ai) {
            const int rowb = u.pm * 256 + ai * 128 + wr * 64, blk = rowb >> 6;
            f32x2 gp[4];
#pragma unroll
            for (int m = 0; m < 4; ++m) {
                const int row = rowb + m * 16 + fr; const float s = rsc.tab[ai * 64 + m * 16 + fr]; const f32x2 s2 = (f32x2){s, s};
                f32x2 g[4], o[4], v[4];
#pragma unroll
                for (int cp = 0; cp < 4; ++cp) { const int n = cp >> 1, e0 = (cp & 1) * 2;
                    g[cp] = (f32x2){acc[ai][0][m][n][e0], acc[ai][0][m][n][e0 + 1]} * s2; v[cp] = (f32x2){acc[ai][1][m][n][e0], acc[ai][1][m][n][e0 + 1]} * s2; }
#pragma unroll
                for (int cp = 0; cp < 4; ++cp) {
                    f32x2 p1 = (f32x2){dppz<0x111>(g[cp].x), dppz<0x111>(g[cp].y)}, p2 = (f32x2){dppz<0x112>(g[cp].x), dppz<0x112>(g[cp].y)};
                    if (m > 0) { p1 += (f32x2){dppz<0x10F>(gp[cp].x), dppz<0x10F>(gp[cp].y)}; p2 += (f32x2){dppz<0x10E>(gp[cp].x), dppz<0x10E>(gp[cp].y)}; }
                    const f32x2 gv = bb[cp] + w0[cp] * p2 + w1[cp] * p1 + w2[cp] * g[cp];
                    const f32x2 ea = gv * (-1.44269504089f);
                    f32x2 ex; ex.x = __builtin_amdgcn_exp2f(ea.x); ex.y = __builtin_amdgcn_exp2f(ea.y);
                    const f32x2 dn = ex + 1.0f;
                    f32x2 rc; rc.x = __builtin_amdgcn_rcpf(dn.x); rc.y = __builtin_amdgcn_rcpf(dn.y);
                    o[cp] = (gv * rc) * v[cp];
                }
                if (m > 0 || fr >= 2) { uint4 w; w.x = pk2(o[0].x, o[0].y); w.y = pk2(o[1].x, o[1].y); w.z = pk2(o[2].x, o[2].y); w.w = pk2(o[3].x, o[3].y); *(uint4*)(act + (size_t)row * FH + ch) = w; }
                if (m == 0 && fr < 2) { uint4 w; w.x = pk2(g[0].x, g[0].y); w.y = pk2(g[1].x, g[1].y); w.z = pk2(g[2].x, g[2].y); w.w = pk2(g[3].x, g[3].y); *(uint4*)(sideg + ((size_t)blk * 4 + fr) * FH + ch) = w;
                    uint4 q; q.x = pk2(v[0].x, v[0].y); q.y = pk2(v[1].x, v[1].y); q.z = pk2(v[2].x, v[2].y); q.w = pk2(v[3].x, v[3].y); *(uint4*)(sidev + ((size_t)blk * 2 + fr) * FH + ch) = q; }
                if (m == 3 && fr >= 14) { uint4 w; w.x = pk2(g[0].x, g[0].y); w.y = pk2(g[1].x, g[1].y); w.z = pk2(g[2].x, g[2].y); w.w = pk2(g[3].x, g[3].y); *(uint4*)(sideg + ((size_t)blk * 4 + 2 + (fr - 14)) * FH + ch) = w; }
#pragma unroll
                for (int cp = 0; cp < 4; ++cp) gp[cp] = g[cp];
            }
        }
    }
};
__device__ __forceinline__ void phase_ffn_fixup(const Args& a, int li, const pg8::StaticOrder& S) {
    bf16_t* act = (bf16_t*)(a.ws + WS_BIG); const bf16_t* sideg = (const bf16_t*)(a.ws + WS_SIDEG); const bf16_t* sidev = (const bf16_t*)(a.ws + WS_SIDEV);
    const float* cw = a.in[17] + (size_t)li * 3 * FH; const float* cb = a.in[18] + (size_t)li * FH;
    const int tid = opaque_tid();
    pg8::Unit u;
    for (int ui = 0; S.next(ui, u); ++ui) {
        if (tid < FH / 8) {
            const int ch = tid * 8;
            float w0[8], w1[8], w2[8], bb[8];
#pragma unroll
            for (int h = 0; h < 2; ++h) { const f32x4 t0 = *(const f32x4*)(cw + ch + 4 * h), t1 = *(const f32x4*)(cw + FH + ch + 4 * h), t2 = *(const f32x4*)(cw + 2 * FH + ch + 4 * h), t3 = *(const f32x4*)(cb + ch + 4 * h);
#pragma unroll
                for (int e = 0; e < 4; ++e) { w0[4 * h + e] = t0[e]; w1[4 * h + e] = t1[e]; w2[4 * h + e] = t2[e]; bb[4 * h + e] = t3[e]; } }
            uint4 pg2[4], pg3[4], og0[4], og1[4], ov0[4], ov1[4];
#pragma unroll
            for (int k = 0; k < 4; ++k) {
                const int blk = u.pm * 4 + k; const bool bstart = (blk & 63) == 0;
                const int pb = bstart ? blk : blk - 1;
                pg2[k] = *(const uint4*)(sideg + ((size_t)pb * 4 + 2) * FH + ch); pg3[k] = *(const uint4*)(sideg + ((size_t)pb * 4 + 3) * FH + ch);
                if (bstart) { pg2[k] = make_uint4(0, 0, 0, 0); pg3[k] = make_uint4(0, 0, 0, 0); }
                og0[k] = *(const uint4*)(sideg + ((size_t)blk * 4 + 0) * FH + ch); og1[k] = *(const uint4*)(sideg + ((size_t)blk * 4 + 1) * FH + ch);
                ov0[k] = *(const uint4*)(sidev + ((size_t)blk * 2 + 0) * FH + ch); ov1[k] = *(const uint4*)(sidev + ((size_t)blk * 2 + 1) * FH + ch);
            }
#pragma unroll
            for (int k = 0; k < 4; ++k) {
                const int blk = u.pm * 4 + k;
                float gm2[8], gm1[8], g0[8], g1[8], v0[8], v1[8], o0[8], o1[8];
                unpack8(pg2[k], gm2); unpack8(pg3[k], gm1); unpack8(og0[k], g0); unpack8(og1[k], g1); unpack8(ov0[k], v0); unpack8(ov1[k], v1);
#pragma unroll
                for (int e = 0; e < 8; ++e) {
                    o0[e] = silu_f(bb[e] + w0[e] * gm2[e] + w1[e] * gm1[e] + w2[e] * g0[e]) * v0[e];
                    o1[e] = silu_f(bb[e] + w0[e] * gm1[e] + w1[e] * g0[e] + w2[e] * g1[e]) * v1[e];
                }
                *(uint4*)(act + (size_t)(blk * 64) * FH + ch) = pack8(o0); *(uint4*)(act + (size_t)(blk * 64 + 1) * FH + ch) = pack8(o1);
            }
        }
    }
    asm volatile("s_waitcnt vmcnt(0)" ::: "memory");
    __syncthreads();
}

__device__ __forceinline__ void p0_transpose_item(const float* W, int K, int N, bf16_t* WT, const float* ks, float* scr, int item, int lane, int ilv) {
    const int nblk = N / 32, kb = item / nblk, nb = item % nblk, k0 = 64 * kb, n0 = 32 * nb;
    const int d0 = ilv == 0 ? n0 : ilv == 1 ? (n0 < FH ? 256 * (n0 / 128) + (n0 % 128) : 256 * ((n0 - FH) / 128) + 128 + ((n0 - FH) % 128))
                 : (n0 < 1024 ? 2048 + n0 : n0 < 2048 ? 256 * ((n0 - 1024) / 128) + ((n0 - 1024) % 128) : 256 * ((n0 - 2048) / 128) + 128 + ((n0 - 2048) % 128));
#pragma unroll 8
    for (int i = 0; i < 32; ++i) { const int kk = 2 * i + (lane >> 5); scr[kk * 33 + (lane & 31)] = W[(size_t)(k0 + kk) * N + n0 + (lane & 31)]; }
    __builtin_amdgcn_fence(__ATOMIC_RELEASE, "wavefront"); __builtin_amdgcn_wave_barrier();
    const int c = lane & 7;
    float sc[8];
#pragma unroll
    for (int q = 0; q < 8; ++q) sc[q] = ks ? ks[k0 + 8 * c + q] : 1.0f;
#pragma unroll
    for (int jj = 0; jj < 4; ++jj) { const int n = (lane >> 3) + 8 * jj; const float* s = scr + (8 * c) * 33 + n;
        uint4 o; o.x = pk2(s[0 * 33] * sc[0], s[1 * 33] * sc[1]); o.y = pk2(s[2 * 33] * sc[2], s[3 * 33] * sc[3]); o.z = pk2(s[4 * 33] * sc[4], s[5 * 33] * sc[5]); o.w = pk2(s[6 * 33] * sc[6], s[7 * 33] * sc[7]);
        *(uint4*)(WT + (size_t)(d0 + n) * K + k0 + 8 * c) = o; }
    __builtin_amdgcn_fence(__ATOMIC_RELEASE, "wavefront"); __builtin_amdgcn_wave_barrier();
}

__device__ __forceinline__ void convert_weights(const Args& a, float* ldsf, unsigned mask, int wb, int nwb) {
    const int tid = opaque_tid(), lane = tid & 63, wave = tid >> 6;
    const int gw = wb * NWAVES + wave, NGW = nwb * NWAVES;
    float* scr = ldsf + wave * 2304;
    unsigned char* ws = a.ws;
    for (int mi = 0; mi < 16; ++mi) {
        if (!((mask >> mi) & 1u)) continue;
        const float* W; bf16_t* WT; const float* ks; int K, N;
        if (mi < 2) { const int j = mi; W = a.in[5] + (size_t)j * 1024 * SSD_IN_N; K = 1024; N = SSD_IN_N; WT = (bf16_t*)(ws + WS_SSDIN + j * SZ_SSDIN1); ks = a.in[1] + (2 * j) * 1024; }
        else if (mi < 4) { const int j = mi - 2; W = a.in[12] + (size_t)j * 2048 * 1024; K = 2048; N = 1024; WT = (bf16_t*)(ws + WS_SSDOUT + j * SZ_SSDOUT1); ks = a.in[11] + j * 2048; }
        else if (mi < 6) { const int j = mi - 4; W = a.in[13] + (size_t)j * 1024 * 3072; K = 1024; N = 3072; WT = (bf16_t*)(ws + WS_SCIN + j * SZ_SCIN1); ks = a.in[1] + (2 * j + 1) * 1024; }
        else if (mi < 8) { const int j = mi - 6; W = a.in[15] + (size_t)j * 1024 * 1024; K = 1024; N = 1024; WT = (bf16_t*)(ws + WS_SCOUT + j * SZ_SCOUT1); ks = nullptr; }
        else if (mi < 12) { const int i = mi - 8; W = a.in[16] + (size_t)i * 1024 * FH2; K = 1024; N = FH2; WT = (bf16_t*)(ws + WS_FUP + i * SZ_FUP1); ks = a.in[3] + i * 1024; }
        else { const int i = mi - 12; W = a.in[19] + (size_t)i * FH * 1024; K = FH; N = 1024; WT = (bf16_t*)(ws + WS_FDN + i * SZ_FDN1); ks = nullptr; }
        const int nitems = (K / 64) * (N / 32);
        for (int it = gw; it < nitems; it += NGW) p0_transpose_item(W, K, N, WT, ks, scr, it, lane, (mi >= 8 && mi < 12) ? 1 : ((mi >= 4 && mi < 6) ? 2 : 0));
    }
}
__device__ __forceinline__ void phase_prep(const Args& a, float* ldsf) {
    const int tid = opaque_tid(), lane = tid & 63, wave = tid >> 6;
    const int gw = blockIdx.x * NWAVES + wave, NGW = gridDim.x * NWAVES;
    unsigned char* ws = a.ws;
    convert_weights(a, ldsf, CONV_PREP_MASK, (int)blockIdx.x, (int)gridDim.x);
    {
        const int gt = blockIdx.x * NTHREADS + tid, NGT = gridDim.x * NTHREADS;
        const int per = (SSD_IN_PAD - SSD_IN_N) * 1024 * 2 / 16;
        for (int i = gt; i < 2 * per; i += NGT) { const int j = i / per, r = i % per; ((uint4*)(ws + WS_SSDIN + j * SZ_SSDIN1 + (size_t)SSD_IN_N * 1024 * 2))[r] = make_uint4(0, 0, 0, 0); }
        for (int i = gt; i < 2 * M_; i += NGT) ((unsigned long long*)(ws + WS_SSQY))[i] = 0ull;
    }
    const float* x = a.in[0]; bf16_t* XB = (bf16_t*)(ws + WS_XB); float* RSX = (float*)(ws + WS_RSX);
    for (int row = gw; row < M_; row += NGW) {
        float s2 = 0.f;
#pragma unroll
        for (int jj = 0; jj < 4; ++jj) {
            const size_t idx = (size_t)row * 1024 + 256 * jj + 4 * lane;
            const f32x4 v = *(const f32x4*)(x + idx);
            u32x2 w; w.x = pk2(v[0], v[1]); w.y = pk2(v[2], v[3]); *(u32x2*)(XB + idx) = w;
            s2 += (v[0] * v[0] + v[1] * v[1]) + (v[2] * v[2] + v[3] * v[3]);
        }
        s2 = wave_sum(s2);
        if (lane == 0) *(f32x4*)(RSX + (size_t)row * 4) = (f32x4){s2, 0.f, 0.f, 0.f};
    }
}

__device__ __forceinline__ void phase_resid(const Args& a, const float* gain, bool last, const bf16_t* F, int ldf) {
    const int tid = opaque_tid(), lane = tid & 63, wave = tid >> 6;
    const int gw = blockIdx.x * NWAVES + wave, NGW = gridDim.x * NWAVES;
    bf16_t* XB = (bf16_t*)(a.ws + WS_XB); float* RSX = (float*)(a.ws + WS_RSX); const float* ssqp = (const float*)(a.ws + WS_SSQP);
    f32x4 g4[4];
#pragma unroll
    for (int jj = 0; jj < 4; ++jj) g4[jj] = *(const f32x4*)(gain + 256 * jj + 4 * lane);
    for (int row = gw; row < M_; row += NGW) {
        float p = lane < 16 ? ssqp[(size_t)row * 16 + lane] : 0.f;
        p = wave_sum(p);
        const float rs = rsqrtf(p * (1.0f / 1024.f) + EPS_);
        float s2 = 0.f;
#pragma unroll
        for (int jj = 0; jj < 4; ++jj) {
            const size_t idx = (size_t)row * 1024 + 256 * jj + 4 * lane;
            const u32x2 xw = *(const u32x2*)(XB + idx);
            const u32x2 fw = *(const u32x2*)(F + (size_t)row * ldf + 256 * jj + 4 * lane);
            f32x4 v;
            v[0] = bf_lo(xw.x) + bf_lo(fw.x) * rs * g4[jj][0]; v[1] = bf_hi(xw.x) + bf_hi(fw.x) * rs * g4[jj][1]; v[2] = bf_lo(xw.y) + bf_lo(fw.y) * rs * g4[jj][2]; v[3] = bf_hi(xw.y) + bf_hi(fw.y) * rs * g4[jj][3];
            if (last) { *(f32x4*)(a.out + idx) = v; }
            else {
                u32x2 w; w.x = pk2(v[0], v[1]); w.y = pk2(v[2], v[3]); *(u32x2*)(XB + idx) = w;
                s2 += (v[0] * v[0] + v[1] * v[1]) + (v[2] * v[2] + v[3] * v[3]);
            }
        }
        if (!last) { s2 = wave_sum(s2); if (lane == 0) *(f32x4*)(RSX + (size_t)row * 4) = (f32x4){s2, 0.f, 0.f, 0.f}; }
    }
}

__device__ __forceinline__ void phase_ffn_conv(const Args& a, int li) {
    bf16_t* BIG = (bf16_t*)(a.ws + WS_BIG);
    const float* cw = a.in[17] + (size_t)li * 3 * FH; const float* cb = a.in[18] + (size_t)li * FH;
    const int gt = blockIdx.x * NTHREADS + opaque_tid(), NGT = gridDim.x * NTHREADS;
    constexpr int C8 = FH / 8, RUN = 16, NITEMS = (M_ / RUN) * C8;
    for (int it = gt; it < NITEMS; it += NGT) {
        const int c8 = it % C8, rb = it / C8, c0 = c8 * 8, row0 = rb * RUN;
        float w0[8], w1[8], w2[8], bb[8];
#pragma unroll
        for (int h = 0; h < 2; ++h) { const f32x4 t0 = *(const f32x4*)(cw + c0 + 4 * h), t1 = *(const f32x4*)(cw + FH + c0 + 4 * h), t2 = *(const f32x4*)(cw + 2 * FH + c0 + 4 * h), t3 = *(const f32x4*)(cb + c0 + 4 * h);
#pragma unroll
            for (int e = 0; e < 4; ++e) { w0[4 * h + e] = t0[e]; w1[4 * h + e] = t1[e]; w2[4 * h + e] = t2[e]; bb[4 * h + e] = t3[e]; } }
        float g0[8], g1[8];
        if ((row0 & (SEQ_ - 1)) == 0) {
#pragma unroll
            for (int e = 0; e < 8; ++e) { g0[e] = 0.f; g1[e] = 0.f; }
        } else {
            unpack8(*(const uint4*)(BIG + (size_t)(row0 - 2) * FH2 + c0), g0); unpack8(*(const uint4*)(BIG + (size_t)(row0 - 1) * FH2 + c0), g1);
        }
#pragma unroll 4
        for (int r = 0; r < RUN; ++r) {
            bf16_t* p = BIG + (size_t)(row0 + r) * FH2 + c0;
            float gc[8], vv[8], o[8];
            unpack8(*(const uint4*)p, gc); unpack8(*(const uint4*)(p + FH), vv);
#pragma unroll
            for (int e = 0; e < 8; ++e) { const float gv = bb[e] + w0[e] * g0[e] + w1[e] * g1[e] + w2[e] * gc[e]; o[e] = silu_f(gv) * vv[e]; g0[e] = g1[e]; g1[e] = gc[e]; }
            *(uint4*)(p + FH) = pack8(o);
        }
    }
}

__device__ __forceinline__ void phase_sc_conv(const Args& a, int j) {
    bf16_t* BIG = (bf16_t*)(a.ws + WS_BIG);
    const float* cw = a.in[14] + (size_t)j * 3 * 1024;
    const int gt = blockIdx.x * NTHREADS + opaque_tid(), NGT = gridDim.x * NTHREADS;
    constexpr int C8 = 1024 / 8, RUN = 16, NITEMS = (M_ / RUN) * C8, LD = 2048;
    for (int it = gt; it < NITEMS; it += NGT) {
        const int c8 = it % C8, rb = it / C8, c0 = c8 * 8, row0 = rb * RUN;
        float w0[8], w1[8], w2[8];
#pragma unroll
        for (int h = 0; h < 2; ++h) { const f32x4 t0 = *(const f32x4*)(cw + c0 + 4 * h), t1 = *(const f32x4*)(cw + 1024 + c0 + 4 * h), t2 = *(const f32x4*)(cw + 2048 + c0 + 4 * h);
#pragma unroll
            for (int e = 0; e < 4; ++e) { w0[4 * h + e] = t0[e]; w1[4 * h + e] = t1[e]; w2[4 * h + e] = t2[e]; } }
        float g0[8], g1[8];
        if ((row0 & (SEQ_ - 1)) == 0) {
#pragma unroll
            for (int e = 0; e < 8; ++e) { g0[e] = 0.f; g1[e] = 0.f; }
        } else {
            unpack8(*(const uint4*)(BIG + (size_t)(row0 - 2) * LD + 1024 + c0), g0); unpack8(*(const uint4*)(BIG + (size_t)(row0 - 1) * LD + 1024 + c0), g1);
        }
#pragma unroll 4
        for (int r = 0; r < RUN; ++r) {
            bf16_t* p = BIG + (size_t)(row0 + r) * LD + c0;
            float gb[8], cur[8], o[8];
            unpack8(*(const uint4*)p, gb); unpack8(*(const uint4*)(p + 1024), cur);
#pragma unroll
            for (int e = 0; e < 8; ++e) { o[e] = gb[e] * (w0[e] * g0[e] + w1[e] * g1[e] + w2[e] * cur[e]); g0[e] = g1[e]; g1[e] = cur[e]; }
            *(uint4*)p = pack8(o);
        }
    }
}

__device__ __forceinline__ void phase_ssd_conv(const Args& a, int j) {
    bf16_t* BIG = (bf16_t*)(a.ws + WS_BIG); const bf16_t* HALO = (const bf16_t*)(a.ws + WS_HALO);
    const float* cw = a.in[6] + (size_t)j * 4 * 4096; const float* cb = a.in[7] + (size_t)j * 4096;
    const int tid = opaque_tid(), lane = tid & 63, wave = tid >> 6;
    const int gw = blockIdx.x * NWAVES + wave, NGW = gridDim.x * NWAVES;
    for (int w = gw; w < 2048; w += NGW) {
        const int cg8 = w & 7, bs = w >> 3, c0 = cg8 * 512 + lane * 8;
        float wt[4][8], bb[8];
#pragma unroll
        for (int h = 0; h < 2; ++h) {
#pragma unroll
            for (int k = 0; k < 4; ++k) { const f32x4 t = *(const f32x4*)(cw + k * 4096 + c0 + 4 * h);
#pragma unroll
                for (int e = 0; e < 4; ++e) wt[k][4 * h + e] = t[e]; }
            const f32x4 t = *(const f32x4*)(cb + c0 + 4 * h);
#pragma unroll
            for (int e = 0; e < 4; ++e) bb[4 * h + e] = t[e];
        }
        float h0[8], h1[8], h2[8];
        if ((bs & 63) == 0) {
#pragma unroll
            for (int e = 0; e < 8; ++e) { h0[e] = 0.f; h1[e] = 0.f; h2[e] = 0.f; }
        } else {
            const bf16_t* hp = HALO + (size_t)(bs - 1) * 3 * 4096 + c0;
            unpack8(*(const uint4*)hp, h0); unpack8(*(const uint4*)(hp + 4096), h1); unpack8(*(const uint4*)(hp + 8192), h2);
        }
        bf16_t* p = BIG + (size_t)bs * 64 * BIGW + DI_ + c0;
#pragma unroll 4
        for (int t = 0; t < 64; ++t) {
            float cur[8], o[8];
            unpack8(*(const uint4*)(p + (size_t)t * BIGW), cur);
#pragma unroll
            for (int e = 0; e < 8; ++e) { const float v = bb[e] + wt[0][e] * h0[e] + wt[1][e] * h1[e] + wt[2][e] * h2[e] + wt[3][e] * cur[e]; o[e] = silu_f(v); h0[e] = h1[e]; h1[e] = h2[e]; h2[e] = cur[e]; }
            *(uint4*)(p + (size_t)t * BIGW) = pack8(o);
        }
    }
}

__device__ __forceinline__ void ssd_dt_job(const Args& a, int j) {
    const bf16_t* XB = (const bf16_t*)(a.ws + WS_XB); const bf16_t* Wdt = (const bf16_t*)(a.ws + WS_SSDIN + j * SZ_SSDIN1) + (size_t)BIGW * 1024;
    const float* RSX = (const float*)(a.ws + WS_RSX); float* DT = (float*)(a.ws + WS_DT); const float* dt_bias = a.in[8] + j * 32;
    const int tid = opaque_tid(), lane = tid & 63, wave = tid >> 6, c16 = lane & 15, q4 = lane >> 4;
    const int gw = blockIdx.x * NWAVES + wave, NGW = gridDim.x * NWAVES;
    for (int rg = gw; rg < M_ / 16; rg += NGW) {
        const int row0 = rg * 16;
        f32x4 d0 = (f32x4){0.f, 0.f, 0.f, 0.f}, d1 = (f32x4){0.f, 0.f, 0.f, 0.f};
        const bf16_t* xp = XB + (size_t)(row0 + c16) * 1024 + q4 * 8; const bf16_t* w0p = Wdt + (size_t)c16 * 1024 + q4 * 8; const bf16_t* w1p = w0p + 16 * 1024;
#pragma unroll 4
        for (int k0 = 0; k0 < 1024; k0 += 32) {
            const bf16x8 xf = *(const bf16x8*)(xp + k0), wf0 = *(const bf16x8*)(w0p + k0), wf1 = *(const bf16x8*)(w1p + k0);
            d0 = __builtin_amdgcn_mfma_f32_16x16x32_bf16(wf0, xf, d0, 0, 0, 0);
            d1 = __builtin_amdgcn_mfma_f32_16x16x32_bf16(wf1, xf, d1, 0, 0, 0);
        }
        const int row = row0 + c16; const float s = rsx(RSX, row);
        const f32x4 b0 = *(const f32x4*)(dt_bias + 4 * q4), b1 = *(const f32x4*)(dt_bias + 16 + 4 * q4);
        f32x4 o0, o1;
#pragma unroll
        for (int e = 0; e < 4; ++e) { o0[e] = softplus_f(d0[e] * s + b0[e]); o1[e] = softplus_f(d1[e] * s + b1[e]); }
        *(f32x4*)(DT + (size_t)row * 32 + 4 * q4) = o0; *(f32x4*)(DT + (size_t)row * 32 + 16 + 4 * q4) = o1;
    }
}

__device__ __forceinline__ void phase_ssd_conv_dt(const Args& a, int j) {
    const int tid = opaque_tid(), lane = tid & 63, wave = tid >> 6;
    const int gw = blockIdx.x * NWAVES + wave, NGW = gridDim.x * NWAVES;
    if (NGW != 2048) { phase_ssd_conv(a, j); ssd_dt_job(a, j); return; }
    bf16_t* BIG = (bf16_t*)(a.ws + WS_BIG); const bf16_t* HALO = (const bf16_t*)(a.ws + WS_HALO);
    const float* cw = a.in[6] + (size_t)j * 4 * 4096; const float* cb = a.in[7] + (size_t)j * 4096;
    const int cg8 = gw & 7, bs = gw >> 3, c0 = cg8 * 512 + lane * 8;
    float wt[4][8], bb[8];
#pragma unroll
    for (int h = 0; h < 2; ++h) {
#pragma unroll
        for (int k = 0; k < 4; ++k) { const f32x4 t = *(const f32x4*)(cw + k * 4096 + c0 + 4 * h);
#pragma unroll
            for (int e = 0; e < 4; ++e) wt[k][4 * h + e] = t[e]; }
        const f32x4 t = *(const f32x4*)(cb + c0 + 4 * h);
#pragma unroll
        for (int e = 0; e < 4; ++e) bb[4 * h + e] = t[e];
    }
    float h0[8], h1[8], h2[8];
    if ((bs & 63) == 0) {
#pragma unroll
        for (int e = 0; e < 8; ++e) { h0[e] = 0.f; h1[e] = 0.f; h2[e] = 0.f; }
    } else {
        const bf16_t* hp = HALO + (size_t)(bs - 1) * 3 * 4096 + c0;
        unpack8(*(const uint4*)hp, h0); unpack8(*(const uint4*)(hp + 4096), h1); unpack8(*(const uint4*)(hp + 8192), h2);
    }
    bf16_t* p = BIG + (size_t)bs * 64 * BIGW + DI_ + c0;
    const bool has_dt = __builtin_amdgcn_readfirstlane(gw) < M_ / 16;
    const int c16 = lane & 15, q4 = lane >> 4, drow0 = (has_dt ? gw : 0) * 16;
    const bf16_t* XB = (const bf16_t*)(a.ws + WS_XB); const bf16_t* Wdt = (const bf16_t*)(a.ws + WS_SSDIN + j * SZ_SSDIN1) + (size_t)BIGW * 1024;
    const bf16_t* xp = XB + (size_t)(drow0 + c16) * 1024 + q4 * 8; const bf16_t* w0p = Wdt + (size_t)c16 * 1024 + q4 * 8; const bf16_t* w1p = w0p + 16 * 1024;
    f32x4 d0 = (f32x4){0.f, 0.f, 0.f, 0.f}, d1 = (f32x4){0.f, 0.f, 0.f, 0.f};
#pragma unroll 4
    for (int t = 0; t < 64; ++t) {
        float cur[8], o[8];
        unpack8(*(const uint4*)(p + (size_t)t * BIGW), cur);
        if (has_dt && !(t & 1)) {
            const int k0 = (t >> 1) * 32;
            const bf16x8 xf = *(const bf16x8*)(xp + k0), wf0 = *(const bf16x8*)(w0p + k0), wf1 = *(const bf16x8*)(w1p + k0);
            d0 = __builtin_amdgcn_mfma_f32_16x16x32_bf16(wf0, xf, d0, 0, 0, 0);
            d1 = __builtin_amdgcn_mfma_f32_16x16x32_bf16(wf1, xf, d1, 0, 0, 0);
        }
#pragma unroll
        for (int e = 0; e < 8; ++e) { const float v = bb[e] + wt[0][e] * h0[e] + wt[1][e] * h1[e] + wt[2][e] * h2[e] + wt[3][e] * cur[e]; o[e] = silu_f(v); h0[e] = h1[e]; h1[e] = h2[e]; h2[e] = cur[e]; }
        *(uint4*)(p + (size_t)t * BIGW) = pack8(o);
    }
    if (has_dt) {
        const float* RSX = (const float*)(a.ws + WS_RSX); float* DT = (float*)(a.ws + WS_DT); const float* dt_bias = a.in[8] + j * 32;
        const int row = drow0 + c16; const float s = rsx(RSX, row);
        const f32x4 b0 = *(const f32x4*)(dt_bias + 4 * q4), b1 = *(const f32x4*)(dt_bias + 16 + 4 * q4);
        f32x4 o0, o1;
#pragma unroll
        for (int e = 0; e < 4; ++e) { o0[e] = softplus_f(d0[e] * s + b0[e]); o1[e] = softplus_f(d1[e] * s + b1[e]); }
        *(f32x4*)(DT + (size_t)row * 32 + 4 * q4) = o0; *(f32x4*)(DT + (size_t)row * 32 + 16 + 4 * q4) = o1;
    }
}

__device__ __forceinline__ void phase_ssd_scan_naive(const Args& a, int j) {
    bf16_t* BIG = (bf16_t*)(a.ws + WS_BIG); const float* DT = (const float*)(a.ws + WS_DT); unsigned long long* SSQY = (unsigned long long*)(a.ws + WS_SSQY) + (size_t)j * M_;
    const float* A_log = a.in[9] + j * 32; const float* Dp = a.in[10] + j * 32;
    const int tid = opaque_tid(), lane = tid & 63, p = tid >> 3, q = tid & 7;
    for (int item = blockIdx.x; item < 128; item += gridDim.x) {
        const int b = item >> 5, h = item & 31, g = h >> 2;
        const float Ah = -__expf(A_log[h]), Dh = Dp[h];
        float st[16];
#pragma unroll
        for (int k = 0; k < 16; ++k) st[k] = 0.f;
        for (int t = 0; t < SEQ_; ++t) {
            const size_t row = (size_t)b * SEQ_ + t;
            bf16_t* r = BIG + row * BIGW;
            const float dtv = DT[row * 32 + h];
            const float xv = bf2f(r[DI_ + h * 64 + p]);
            const float zv = bf2f(r[h * 64 + p]);
            float Bf[16], Cf[16];
            unpack8(*(const uint4*)(r + 4096 + g * 128 + q * 16), Bf); unpack8(*(const uint4*)(r + 4096 + g * 128 + q * 16 + 8), Bf + 8);
            unpack8(*(const uint4*)(r + 5120 + g * 128 + q * 16), Cf); unpack8(*(const uint4*)(r + 5120 + g * 128 + q * 16 + 8), Cf + 8);
            const float dA = __expf(dtv * Ah), xdt = xv * dtv;
            float acc = 0.f;
#pragma unroll
            for (int k = 0; k < 16; ++k) { st[k] = st[k] * dA + xdt * Bf[k]; acc += Cf[k] * st[k]; }
            acc += __shfl_xor(acc, 1); acc += __shfl_xor(acc, 2); acc += __shfl_xor(acc, 4);
            const float y = acc + Dh * xv;
            const float yg = y * silu_f(zv);
            float sq = (q == 0) ? yg * yg : 0.f;
            sq = wave_sum(sq);
            if (q == 0) r[h * 64 + p] = (bf16_t)(pk2(yg, 0.f) & 0xffffu);
            if (lane == 0) atomicAdd(&SSQY[row], (unsigned long long)(sq * SSQ_FIX + 0.5f));
        }
    }
}


struct SsdRegs { uint4 rb[2], rc[2], rx; u32x2 rz; float rdt; };
struct SsdItem { int b, h, ph, g; float Ah, Dh; unsigned offB[2], offC[2], offX, offZ, offDT; };
__device__ __forceinline__ void ssd_load(SsdRegs& R, const bf16_t* BIG, const float* DT, const SsdItem& I, int cc, int wave) {
    const size_t r0 = (size_t)I.b * SEQ_ + (size_t)cc * 64;
    const char* cb = (const char*)BIG + r0 * (BIGW * 2); const char* cd = (const char*)DT + r0 * 128;
#pragma unroll
    for (int i = 0; i < 2; ++i) { R.rb[i] = *(const uint4*)(cb + I.offB[i]); R.rc[i] = *(const uint4*)(cb + I.offC[i]); }
    if (wave < 4) R.rx = *(const uint4*)(cb + I.offX);
    R.rz = *(const u32x2*)(cb + I.offZ);
    R.rdt = *(const float*)(cd + I.offDT);
}
template <bool DRY>
__device__ __forceinline__ void ssd_chunk(SsdRegs& R, f32x4 (&st)[2], LAS unsigned char* L, bf16_t* BIG, const float* DT, float* SSQY, const SsdItem& I, int c, int tid, int lane, int wave, int li, int pi, int c16, int q4) {
    constexpr int PC = 272, PT = 144;
    constexpr int PB = 288, PX = 96;
    constexpr int CS = 0, BS = 17408, BW = 34816, XI0 = 53248, GG = 65536, SB0 = 74752, SCT = 92160;
    const int XI = XI0 + (c & 1) * 6144, SB = SB0 + (c & 1) * 8704;
    const int trB = (8 * q4 + (c16 >> 2)) * PB + (c16 & 3) * 8, trX = (8 * q4 + (c16 >> 2)) * PX + (c16 & 3) * 8;
#define SSD_TR(base, pitch, troff, ct, kk) __builtin_shufflevector( \
        __builtin_amdgcn_ds_read_tr16_b64_v4i16((LAS s16x4*)(L + (base) + (troff) + (kk) * 32 * (pitch) + (ct) * 32)), \
        __builtin_amdgcn_ds_read_tr16_b64_v4i16((LAS s16x4*)(L + (base) + (troff) + (kk) * 32 * (pitch) + 4 * (pitch) + (ct) * 32)), 0, 1, 2, 3, 4, 5, 6, 7)
#define SSD_FRAG(base, pitch, r0, kk) (*(const LAS bf16x8*)(L + (base) + ((r0) + c16) * (pitch) + (kk) * 64 + q4 * 16))
    const size_t row0 = (size_t)I.b * SEQ_ + (size_t)c * 64;
    const float dtl = R.rdt;
    float acs = dtl * I.Ah;
    acs += dppz<0x111>(acs); acs += dppz<0x112>(acs); acs += dppz<0x114>(acs); acs += dppz<0x118>(acs);
    acs += __builtin_bit_cast(float, __builtin_amdgcn_update_dpp(0, __builtin_bit_cast(int, acs), 0x142, 0xa, 0xf, false));
    acs += __builtin_bit_cast(float, __builtin_amdgcn_update_dpp(0, __builtin_bit_cast(int, acs), 0x143, 0xc, 0xf, false));
    const float tot = __builtin_bit_cast(float, __builtin_amdgcn_readlane(__builtin_bit_cast(int, acs), 63));
    const float wl = dtl * __expf(tot - acs), etot = __expf(tot);
    LAS unsigned char* SCW = L + SCT + wave * 512;
    *(LAS float*)(SCW + lane * 4) = acs; *(LAS float*)(SCW + 256 + lane * 4) = dtl;
#pragma unroll
    for (int pt = 0; pt < 2; ++pt) { u32x2 w; w.x = pk2(st[pt][0], st[pt][1]); w.y = pk2(st[pt][2], st[pt][3]); *(LAS u32x2*)(L + SB + (16 * pt + c16) * PC + (16 * wave + 4 * q4) * 2) = w; }
#pragma unroll
    for (int i = 0; i < 2; ++i) {
        const int id = tid + 512 * i; *(LAS u32x4*)(L + CS + (id >> 4) * PC + (id & 15) * 16) = (u32x4){R.rc[i].x, R.rc[i].y, R.rc[i].z, R.rc[i].w};
        const int n8 = wave + 8 * i; *(LAS u32x4*)(L + BS + lane * PC + n8 * 16) = (u32x4){R.rb[i].x, R.rb[i].y, R.rb[i].z, R.rb[i].w};
        float f[8]; unpack8(R.rb[i], f);
        u32x4 bwv; bwv.x = pk2(f[0] * wl, f[1] * wl); bwv.y = pk2(f[2] * wl, f[3] * wl); bwv.z = pk2(f[4] * wl, f[5] * wl); bwv.w = pk2(f[6] * wl, f[7] * wl);
        *(LAS u32x4*)(L + BW + lane * PB + n8 * 16) = bwv;
    }
    if (wave < 4) *(LAS u32x4*)(L + XI + lane * PX + wave * 16) = (u32x4){R.rx.x, R.rx.y, R.rx.z, R.rx.w};
    const u32x2 zc = R.rz;
    __syncthreads();
    if (c + 2 < 64) ssd_load(R, BIG, DT, I, c + 2, wave);
    bf16x8 cfr[4];
#pragma unroll
    for (int kk = 0; kk < 4; ++kk) cfr[kk] = SSD_FRAG(CS, PC, 16 * li, kk);
    {
        const int l = 16 * li + c16; const float acs_l = *(const LAS float*)(SCW + l * 4);
#pragma unroll
        for (int t = 0; t < 2; ++t) {
            const int si = 2 * pi + t;
            u32x2 w; w.x = 0u; w.y = 0u;
            if (si <= li) {
                f32x4 d = (f32x4){0.f, 0.f, 0.f, 0.f};
#pragma unroll
                for (int kk = 0; kk < 4; ++kk) d = __builtin_amdgcn_mfma_f32_16x16x32_bf16(SSD_FRAG(BS, PC, 16 * si, kk), cfr[kk], d, 0, 0, 0);
                float gv[4];
                const f32x4 acs_s = *(const LAS f32x4*)(SCW + (16 * si + 4 * q4) * 4), dt_s = *(const LAS f32x4*)(SCW + 256 + (16 * si + 4 * q4) * 4);
#pragma unroll
                for (int e = 0; e < 4; ++e) gv[e] = d[e] * __expf(acs_l - acs_s[e]) * dt_s[e];
                if (si == li) {
#pragma unroll
                    for (int e = 0; e < 4; ++e) gv[e] = (4 * q4 + e <= c16) ? gv[e] : 0.f;
                }
                w.x = pk2(gv[0], gv[1]); w.y = pk2(gv[2], gv[3]);
            }
            *(LAS u32x2*)(L + GG + l * PT + (16 * si + 4 * q4) * 2) = w;
        }
    }
    f32x4 stn[2];
    bf16x8 xfr[2][2], bwf[2];
#pragma unroll
    for (int kk = 0; kk < 2; ++kk) { bwf[kk] = SSD_TR(BW, PB, trB, wave, kk); xfr[0][kk] = SSD_TR(XI, PX, trX, 0, kk); xfr[1][kk] = SSD_TR(XI, PX, trX, 1, kk); }
#pragma unroll
    for (int pt = 0; pt < 2; ++pt) {
        f32x4 d = st[pt] * etot;
#pragma unroll
        for (int kk = 0; kk < 2; ++kk) d = __builtin_amdgcn_mfma_f32_16x16x32_bf16(bwf[kk], xfr[pt][kk], d, 0, 0, 0);
        stn[pt] = d;
    }
    const bf16x8 xy0 = pi ? xfr[1][0] : xfr[0][0], xy1 = pi ? xfr[1][1] : xfr[0][1];
    st[0] = stn[0]; st[1] = stn[1];
    __syncthreads();
    {
        f32x4 d1 = (f32x4){0.f, 0.f, 0.f, 0.f}, d2 = (f32x4){0.f, 0.f, 0.f, 0.f};
#pragma unroll
        for (int kk = 0; kk < 2; ++kk) d1 = __builtin_amdgcn_mfma_f32_16x16x32_bf16(kk ? xy1 : xy0, SSD_FRAG(GG, PT, 16 * li, kk), d1, 0, 0, 0);
#pragma unroll
        for (int kk = 0; kk < 4; ++kk) d2 = __builtin_amdgcn_mfma_f32_16x16x32_bf16(SSD_FRAG(SB, PC, 16 * pi, kk), cfr[kk], d2, 0, 0, 0);
        const int l = 16 * li + c16; const float ea_l = __expf(*(const LAS float*)(SCW + l * 4));
        const float zf[4] = {bf_lo(zc.x), bf_hi(zc.x), bf_lo(zc.y), bf_hi(zc.y)};
        float yg[4], sq = 0.f;
        const u32x2 xr = *(const LAS u32x2*)(L + XI + l * PX + (16 * pi + 4 * q4) * 2);
        const float xs[4] = {bf_lo(xr.x), bf_hi(xr.x), bf_lo(xr.y), bf_hi(xr.y)};
#pragma unroll
        for (int e = 0; e < 4; ++e) { const float xv = xs[e];
            const float y = d1[e] + ea_l * d2[e] + I.Dh * xv; yg[e] = y * silu_f(zf[e]); sq += yg[e] * yg[e]; }
        u32x2 w; w.x = pk2(yg[0], yg[1]); w.y = pk2(yg[2], yg[3]);
        if (!DRY) *(u32x2*)((char*)BIG + row0 * (BIGW * 2) + I.offZ) = w;
        sq += __shfl_xor(sq, 16); sq += __shfl_xor(sq, 32);
        if (DRY) { if (sq == 12345.678f) SSQY[0] = 1.f; } else if (q4 == 0) SSQY[(size_t)(I.h * 4 + I.ph * 2 + pi) * M_ + row0 + l] = sq;
    }
#undef SSD_FRAG
#undef SSD_TR
}
template <bool DRY>
__device__ __forceinline__ void phase_ssd_scan(const Args& a, int j, unsigned char* lds_raw) {
    LAS unsigned char* L = (LAS unsigned char*)lds_raw;
    bf16_t* BIG = (bf16_t*)(a.ws + WS_BIG); const float* DT = (const float*)(a.ws + WS_DT); float* SSQY = (float*)(a.ws + WS_SSQ128);
    const float* A_log = a.in[9] + j * 32; const float* Dp = a.in[10] + j * 32;
    const int tid = opaque_tid(), lane = tid & 63, wave = __builtin_amdgcn_readfirstlane(tid >> 6);
    const int role = (wave == 1) ? 6 : ((wave == 6) ? 1 : wave);
    const int c16 = lane & 15, q4 = lane >> 4, li = role >> 1, pi = role & 1;
    for (int it = blockIdx.x; it < 256; it += gridDim.x) {
        const int xc = it & 7, slot = it >> 3, pair = xc + 8 * (slot >> 3), sub = slot & 7;
        SsdItem I; I.b = pair >> 3; I.g = pair & 7; I.h = I.g * 4 + (sub >> 1); I.ph = sub & 1;
        I.Ah = -__expf(A_log[I.h]); I.Dh = Dp[I.h];
#pragma unroll
        for (int i = 0; i < 2; ++i) { I.offB[i] = (unsigned)(lane * BIGW + 4096 + I.g * 128 + (wave + 8 * i) * 8) * 2u; const int id = tid + 512 * i; I.offC[i] = (unsigned)((id >> 4) * BIGW + 5120 + I.g * 128 + (id & 15) * 8) * 2u; }
        I.offX = (unsigned)(lane * BIGW + DI_ + I.h * 64 + I.ph * 32 + wave * 8) * 2u;
        I.offZ = (unsigned)((16 * li + c16) * BIGW + I.h * 64 + I.ph * 32 + 16 * pi + 4 * q4) * 2u;
        I.offDT = (unsigned)(lane * 32 + I.h) * 4u;
        f32x4 st[2]; st[0] = (f32x4){0.f, 0.f, 0.f, 0.f}; st[1] = (f32x4){0.f, 0.f, 0.f, 0.f};
        SsdRegs R0, R1; R0.rx = make_uint4(0, 0, 0, 0); R1.rx = make_uint4(0, 0, 0, 0);
        ssd_load(R0, BIG, DT, I, 0, wave);
        ssd_load(R1, BIG, DT, I, 1, wave);
        for (int c = 0; c < 64; c += 2) {
            ssd_chunk<DRY>(R0, st, L, BIG, DT, SSQY, I, c, tid, lane, wave, li, pi, c16, q4);
            ssd_chunk<DRY>(R1, st, L, BIG, DT, SSQY, I, c + 1, tid, lane, wave, li, pi, c16, q4);
        }
    }
}

constexpr int NPH = 1 + 9 * 4;
__host__ __device__ inline bool phase_exists(int ph) { if (ph == 0) return true; const int li = (ph - 1) / 9, s = (ph - 1) % 9; return !((li & 1) && s == 2) && s != 6; }

__global__ void __launch_bounds__(NTHREADS, 2) mk_fwd(Args a) {
    extern __shared__ __attribute__((aligned(16))) unsigned char lds[];
    unsigned char* ws = a.ws;
    bf16_t* XB = (bf16_t*)(ws + WS_XB); bf16_t* BIG = (bf16_t*)(ws + WS_BIG); float* RSX = (float*)(ws + WS_RSX); float* SSQP = (float*)(ws + WS_SSQP);
    volatile LAS unsigned* bst = (volatile LAS unsigned*)((LAS unsigned char*)lds + 131072);
    if (threadIdx.x == 0) { bst[0] = 0u; bst[1] = 0u; }
    __syncthreads();
    (void)xcd_barrier_post((unsigned*)(ws + WS_BAR), bst);
    const bool fusedres = (FUSE_RESID != 0) && (gridDim.x == 256) && (a.ph_hi - a.ph_lo > 1);
    bool first = true;
    for (int ph = a.ph_lo; ph < a.ph_hi; ++ph) {
        if (!phase_exists(ph)) continue;
        if (fusedres && ph > 0 && ((ph - 1) % 9 == 4 || (ph - 1) % 9 == 8)) continue;
        if (!first) { XcdBarrier xbar; xbar.bar = (unsigned*)(ws + WS_BAR); xbar.x = xb_xcc_id(); xbar.st = bst; xcd_barrier(xbar); if (PROBE == 2) xcd_barrier(xbar); }
        first = false;
        if (ph == 0) { phase_prep(a, (float*)lds); continue; }
        const int li = (ph - 1) / 9, s = (ph - 1) % 9, j = li >> 1; const bool ssd = !(li & 1);
        int kind = -1; const bf16_t* A = nullptr; int lda = 0; const bf16_t* Bt = nullptr; int N = 0, K = 0;
        bf16_t* outp = nullptr; int ldc = 0; const float* ssq_in = nullptr; float inv_k = 0.f;
        if (s == 0 && ssd) { kind = 0; A = XB; lda = 1024; Bt = (const bf16_t*)(ws + WS_SSDIN + j * SZ_SSDIN1); N = BIGW; K = 1024; }
        else if (s == 0) { kind = 1; A = XB; lda = 1024; Bt = (const bf16_t*)(ws + WS_SCIN + j * SZ_SCIN1); N = SCW3; K = 1024; outp = BIG; ldc = 2048; }
        else if (s == 5) { kind = 3; A = XB; lda = 1024; Bt = (const bf16_t*)(ws + WS_FUP + li * SZ_FUP1); N = FH2; K = 1024; }
        else if (s == 3 && ssd) { kind = 2; A = BIG; lda = BIGW; Bt = (const bf16_t*)(ws + WS_SSDOUT + j * SZ_SSDOUT1); N = 1024; K = DI_; outp = BIG + DI_; ldc = BIGW; ssq_in = (const float*)(ws + WS_SSQ128); inv_k = 1.0f / 2048.f; }
        else if (s == 3) { kind = 2; A = BIG; lda = 2048; Bt = (const bf16_t*)(ws + WS_SCOUT + j * SZ_SCOUT1); N = 1024; K = 1024; outp = BIG + 1024; ldc = 2048; }
        else if (s == 7) { kind = 2; A = BIG; lda = FH; Bt = (const bf16_t*)(ws + WS_FDN + li * SZ_FDN1); N = 1024; K = FH; outp = BIG + (size_t)M_ * FH; ldc = 1024; }
        if (kind >= 0) {
          for (int rep = 0; rep < (PROBE == 1 ? 2 : 1); ++rep) {
#if FAST_GEMM
            pg8::Gemm g{A, lda, Bt, M_, N, K}; pg8::StaticOrder S; S.init(M_, N, (int)gridDim.x, (int)blockIdx.x);
            if (s == 7) phase_ffn_fixup(a, li, S);
            if (kind == 0) { EpiSsdIn E{BIG, (float*)(ws + WS_DT), (bf16_t*)(ws + WS_HALO), RSX, a.in[8] + j * 32}; pg8::gemm_phase<EpiSsdIn>((LAS unsigned char*)lds, g, S, E); }
            else if (kind == 1) { EpiPlain E{outp, ldc, RSX}; pg8::gemm_phase<EpiPlain>((LAS unsigned char*)lds, g, S, E); }
            else if (kind == 3) { EpiFfnUp E{BIG, RSX, a.in[17] + (size_t)li * 3 * FH, a.in[18] + (size_t)li * FH, (bf16_t*)(ws + WS_SIDEG), (bf16_t*)(ws + WS_SIDEV)}; pg8::gemm_phase<EpiFfnUp>((LAS unsigned char*)lds, g, S, E); }
            else if (fusedres) { EpiOutFused E{ssq_in, inv_k, XB, (li == 3 && s == 7) ? a.out : nullptr, (s == 3 ? a.in[2] : a.in[4]) + li * 1024, RSX, (float*)(ws + WS_XCH), (unsigned*)(ws + WS_CNT), 16u * (unsigned)(li * 2 + (s == 7 ? 1 : 0) + 1)};
                pg8::gemm_phase<EpiOutFused>((LAS unsigned char*)lds, g, S, E); }
            else { EpiOut E{outp, ldc, ssq_in, inv_k, SSQP}; pg8::gemm_phase<EpiOut>((LAS unsigned char*)lds, g, S, E); }
#if HIDE_CONV
            if (rep == 0) {
                unsigned cmask = 0u;
                if (s == 0 && li == 0) cmask = (1u << 2) | (1u << 8) | (1u << 12);
                else if (s == 5 && li == 0) cmask = (1u << 4) | (1u << 6) | (1u << 9) | (1u << 13);
                else if (s == 5 && li == 1) cmask = (1u << 1) | (1u << 3) | (1u << 10) | (1u << 14);
                else if (s == 0 && li == 2) cmask = (1u << 5) | (1u << 7) | (1u << 11) | (1u << 15);
                if (cmask) {
                    const int G = (int)gridDim.x, rem = S.nwg % G;
                    if (rem == 0) convert_weights(a, (float*)lds, cmask, (int)blockIdx.x, G);
                    else if ((int)blockIdx.x >= rem) convert_weights(a, (float*)lds, cmask, (int)blockIdx.x - rem, G - rem);
                }
            }
#endif
#else
            if (kind == 0) { EpiSsdIn E{BIG, (float*)(ws + WS_DT), (bf16_t*)(ws + WS_HALO), RSX, a.in[8] + j * 32}; gemm_naive<EpiSsdIn>((float*)lds, A, lda, Bt, N, K, E); }
            else if (kind == 1) { EpiPlain E{outp, ldc, RSX}; gemm_naive<EpiPlain>((float*)lds, A, lda, Bt, N, K, E); }
            else { EpiOut E{outp, ldc, ssq_in, inv_k, SSQP}; gemm_naive<EpiOut>((float*)lds, A, lda, Bt, N, K, E); }
#endif
          }
            continue;
        }
        if (s == 1) { if (ssd) phase_ssd_conv_dt(a, j); else phase_sc_conv(a, j); }
        else if (s == 2) {
#if FAST_SSD
            if (PROBE == 3) { phase_ssd_scan<true>(a, j, lds); __syncthreads(); }
            phase_ssd_scan<false>(a, j, lds);
#else
            phase_ssd_scan_naive(a, j);
#endif
        }
        else if (s == 4) { phase_resid(a, a.in[2] + li * 1024, false, ssd ? BIG + DI_ : BIG + 1024, ssd ? BIGW : 2048); }
        else if (s == 8) { phase_resid(a, a.in[4] + li * 1024, li == 3, BIG + (size_t)M_ * FH, 1024); }
    }
}

extern "C" void kernel_launch(void* const* d_in, const int* in_sizes, int n_in, void* d_out, int out_size, void* d_ws, size_t ws_size, hipStream_t stream) {
    static int grid = 0;
    if (grid == 0) {
        if (n_in != 20 || out_size != M_ * D_ || ws_size < WS_END) { fprintf(stderr, "kernel_launch: unexpected shapes (n_in %d out %d ws %zu need %zu)\n", n_in, out_size, ws_size, (size_t)WS_END); grid = -1; return; }
        int dev = 0, cus = 0, per_cu = 0;
        (void)hipGetDevice(&dev); (void)hipDeviceGetAttribute(&cus, hipDeviceAttributeMultiprocessorCount, dev);
        if (hipFuncSetAttribute((const void*)mk_fwd, hipFuncAttributeMaxDynamicSharedMemorySize, LDS_BYTES) != hipSuccess) { fprintf(stderr, "kernel_launch: hipFuncSetAttribute failed\n"); grid = -1; return; }
        if (hipOccupancyMaxActiveBlocksPerMultiprocessor(&per_cu, (const void*)mk_fwd, NTHREADS, LDS_BYTES) != hipSuccess || per_cu < 1) { fprintf(stderr, "kernel_launch: occupancy query failed (%d)\n", per_cu); (void)hipGetLastError(); per_cu = 1; }
        if (per_cu > 1) per_cu = 1;
        grid = cus * per_cu;
        fprintf(stderr, "kernel_launch: grid %d (cus %d), ws %zu need %zu\n", grid, cus, ws_size, (size_t)WS_END);
    }
    if (grid < 0) return;
    Args a{};
    for (int i = 0; i < 20; ++i) a.in[i] = (const float*)d_in[i];
    a.out = (float*)d_out; a.ws = (unsigned char*)d_ws;
    if (hipMemsetAsync((unsigned char*)d_ws + WS_BAR, 0, 32768, stream) != hipSuccess) { fprintf(stderr, "kernel_launch: memset of the barrier words failed\n"); return; }
#if ONE_LAUNCH
    a.ph_lo = 0; a.ph_hi = NPH;
    void* args[] = {&a};
    hipError_t e = hipLaunchCooperativeKernel((const void*)mk_fwd, dim3(grid), dim3(NTHREADS), args, LDS_BYTES, stream);
    if (e != hipSuccess) fprintf(stderr, "cooperative launch failed: %s (grid %d)\n", hipGetErrorString(e), grid);
#else
    for (int ph = 0; ph < NPH; ++ph) {
        if (!phase_exists(ph)) continue;
        a.ph_lo = ph; a.ph_hi = ph + 1;
        hipLaunchKernelGGL(mk_fwd, dim3(grid), dim3(NTHREADS), LDS_BYTES, stream, a);
    }
#endif
}
```
